# Optimizing an MI355X kernel written in HIP

```python
import math
import jax
import jax.numpy as jnp
from jax import lax
import numpy as np

D_MODEL = 2048
BATCH = 4
SEQ = 4096
DEPTH = 4

GRID_W = 64
CTX_LEN = 256
EPS = 1e-6
NEG_INF = -1e30
F32 = jnp.float32

D_BRANCH = 512
D_MIX = 4 * D_BRANCH
SHORT_CONV = 3

GDN_HEADS = 4
GDN_DK = 128
GDN_DV = 128
GDN_W = GDN_HEADS * GDN_DV
GDN_CHUNK = 64

NA_HEADS = 4
NA_DH = 128
NA_W = NA_HEADS * NA_DH
NA_WIN_R = 8
NA_WIN_C = 16
NA_QBLK_C = 16
NA_KBLK_C = 32

MLA_HEADS = 4
MLA_Q_RANK = 384
MLA_KV_RANK = 256
MLA_NOPE = 128
MLA_ROPE = 64
MLA_V = 128
MLA_W = MLA_HEADS * MLA_V
MLA_QBLOCK = 128
ROPE_THETA = 10000.0

SSM_HEADDIM = 64
SSM_HEADS = D_BRANCH // SSM_HEADDIM
SSM_W = SSM_HEADS * SSM_HEADDIM
SSM_GROUPS = 2
SSM_STATE = 128
SSM_CONV_DIM = SSM_W + 2 * SSM_GROUPS * SSM_STATE
SSM_CHUNK = 64

IN_SIZES = (3 * GDN_W, GDN_W, 2 * GDN_HEADS, 2 * GDN_HEADS,
            3 * NA_W, NA_W,
            MLA_Q_RANK, MLA_KV_RANK, MLA_ROPE, MLA_W,
            SSM_W, SSM_CONV_DIM, 2 * SSM_HEADS)
D_IN = sum(IN_SIZES)

kernel_name = 'hybrid_parallel_heads_diffusion_block'


def rmsnorm(x, w):
    xf = x.astype(F32)
    y = xf * lax.rsqrt(jnp.mean(xf * xf, axis=-1, keepdims=True) + EPS)
    return (y * w.astype(F32)).astype(x.dtype)


def l2norm(x):
    xf = x.astype(F32)
    return xf * lax.rsqrt(jnp.sum(xf * xf, axis=-1, keepdims=True) + EPS)


def dwconv_centred(x, w):
    k = w.shape[0]
    return lax.conv_general_dilated(x, w[:, None, :].astype(x.dtype), window_strides=(1,),
                                    padding=[(k // 2, k // 2)],
                                    dimension_numbers=('NWC', 'WIO', 'NWC'),
                                    feature_group_count=x.shape[-1])


def split_in(t):
    out, start = [], 0
    for size in IN_SIZES:
        out.append(t[..., start:start + size])
        start += size
    return out


def rotate_pairs(x, ang):
    cos = jnp.cos(ang)[:, None, :].astype(x.dtype)
    sin = jnp.sin(ang)[:, None, :].astype(x.dtype)
    x1, x2 = jnp.split(x, 2, axis=-1)
    return jnp.concatenate([x1 * cos - x2 * sin, x2 * cos + x1 * sin], axis=-1)


def axial_rope_2d(x):
    T, n_freq = x.shape[1], x.shape[-1] // 4
    inv_freq = ROPE_THETA ** (-jnp.arange(n_freq, dtype=F32) / n_freq)
    t = jnp.arange(T, dtype=jnp.int32)
    row = (t // GRID_W).astype(F32)
    col = (t % GRID_W).astype(F32)
    x_row, x_col = jnp.split(x, 2, axis=-1)
    return jnp.concatenate([rotate_pairs(x_row, row[:, None] * inv_freq),
                            rotate_pairs(x_col, col[:, None] * inv_freq)], axis=-1)


def softmax_attention(q, k, v, scale):
    s = jnp.einsum('bqhd,bkhd->bhqk', q, k).astype(F32) * scale
    p = jax.nn.softmax(s, axis=-1).astype(v.dtype)
    return jnp.einsum('bhqk,bkhd->bqhd', p, v)


def blocked_attention(q, k, v, scale):
    Bsz, T, H, dq = q.shape
    nb = T // MLA_QBLOCK
    qb = jnp.moveaxis(q.reshape(Bsz, nb, MLA_QBLOCK, H, dq), 1, 0)
    o = lax.map(lambda qblk: softmax_attention(qblk, k, v, scale), qb)
    return jnp.moveaxis(o, 0, 1).reshape(Bsz, T, H, v.shape[-1])


def gdn_scan(q, k, v, g, beta, S0):
    Bsz, H, T, dk = q.shape
    dv = v.shape[-1]
    C = GDN_CHUNK
    n = T // C
    q = q.reshape(Bsz, H, n, C, dk)
    k = k.reshape(Bsz, H, n, C, dk)
    v = v.reshape(Bsz, H, n, C, dv)
    g = g.reshape(Bsz, H, n, C)
    beta = beta.reshape(Bsz, H, n, C)
    gam = jnp.cumsum(g, axis=-1)
    incl = np.tril(np.ones((C, C), bool))
    strict = np.tril(np.ones((C, C), bool), -1)
    diff = gam[..., :, None] - gam[..., None, :]
    dec = jnp.where(incl, jnp.exp(jnp.where(incl, diff, 0.0)), 0.0)
    kk = jnp.einsum('bhnid,bhnjd->bhnij', k, k)
    A = jnp.where(strict, beta[..., :, None] * kk * dec, 0.0)
    eye = jnp.eye(C, dtype=F32)
    T_inv = lax.linalg.triangular_solve(A + eye, jnp.broadcast_to(eye, A.shape), left_side=True,
                                        lower=True, unit_diagonal=True)
    u = jnp.einsum('bhnij,bhnjd->bhnid', T_inv, v * beta[..., None])
    w = jnp.einsum('bhnij,bhnjd->bhnid', T_inv, k * (beta * jnp.exp(gam))[..., None])
    qk = jnp.einsum('bhnid,bhnjd->bhnij', q, k) * dec
    g_last = gam[..., -1]
    q_dec = q * jnp.exp(gam)[..., None]
    k_dec = k * jnp.exp(g_last[..., None] - gam)[..., None]

    def step(S, inp):
        qd, kd, uc, wc, qkc, glc = inp
        v_new = uc - jnp.einsum('bhid,bhde->bhie', wc, S)
        o = jnp.einsum('bhid,bhde->bhie', qd, S) + jnp.einsum('bhij,bhje->bhie', qkc, v_new)
        S = S * jnp.exp(glc)[..., None, None] + jnp.einsum('bhid,bhie->bhde', kd, v_new)
        return S, o

    xs = tuple(jnp.moveaxis(t, 2, 0) for t in (q_dec, k_dec, u, w, qk, g_last))
    S_last, o = lax.scan(step, S0, xs)
    return jnp.moveaxis(o, 0, 2).reshape(Bsz, H, T, dv), S_last


def gdn_branch(qkv, z, beta_in, alpha_in, qkv_c, z_c, beta_in_c, alpha_in_c,
               conv_w, A_log, dt_bias, norm_w):
    decay_rate = jnp.exp(A_log.astype(F32))

    def prep(qkv, beta_in, alpha_in):
        Bsz, T, _ = qkv.shape
        qkv = jax.nn.silu(dwconv_centred(qkv, conv_w))
        t = qkv.astype(F32).reshape(Bsz, T, 3, GDN_HEADS, GDN_DK).transpose(2, 0, 3, 1, 4)
        q = l2norm(t[0]) * GDN_DK ** -0.5
        k = l2norm(t[1])
        v = t[2]
        beta = jax.nn.sigmoid(beta_in.astype(F32)).reshape(Bsz, T, 2, GDN_HEADS).transpose(2, 0, 3, 1)
        g = -decay_rate * jax.nn.softplus(alpha_in.astype(F32).reshape(Bsz, T, 2, GDN_HEADS)
                                          + dt_bias.astype(F32))
        return q, k, v, g.transpose(2, 0, 3, 1), beta

    def flip(t):
        return jnp.flip(t, axis=2)

    ql, kl, vl, gl, bl = prep(qkv, beta_in, alpha_in)
    qc, kc, vc, gc, bc = prep(qkv_c, beta_in_c, alpha_in_c)
    S0 = jnp.zeros((qc.shape[0], GDN_HEADS, GDN_DK, GDN_DV), F32)
    oc_f, Sc_f = gdn_scan(qc, kc, vc, gc[0], bc[0], S0)
    ol_f, _ = gdn_scan(ql, kl, vl, gl[0], bl[0], Sc_f)
    oc_b, Sc_b = gdn_scan(flip(qc), flip(kc), flip(vc), flip(gc[1]), flip(bc[1]), S0)
    ol_b, _ = gdn_scan(flip(ql), flip(kl), flip(vl), flip(gl[1]), flip(bl[1]), Sc_b)

    def out(o, z):
        Bsz, H, T, dv = o.shape
        o = rmsnorm(o.transpose(0, 2, 1, 3), norm_w).reshape(Bsz, T, GDN_W)
        return o.astype(z.dtype) * jax.nn.silu(z)

    return out(ol_f + flip(ol_b), z), out(oc_f + flip(oc_b), z_c)


def na_block_indices(rows):
    wr = min(NA_WIN_R, rows)
    ncb = GRID_W // NA_QBLK_C
    r = np.arange(rows)
    row0 = np.clip(r - wr // 2, 0, rows - wr)
    key_rows = row0[:, None] + np.arange(wr)
    cb = np.arange(ncb)
    col0 = np.clip(cb * NA_QBLK_C - (NA_KBLK_C - NA_QBLK_C) // 2, 0, GRID_W - NA_KBLK_C)
    key_cols = col0[:, None] + np.arange(NA_KBLK_C)
    kn = wr * NA_KBLK_C
    kidx = (key_rows[:, None, :, None] * GRID_W + key_cols[None, :, None, :]).reshape(rows, ncb, kn)
    kcol = np.broadcast_to(key_cols[:, None, :], (ncb, wr, NA_KBLK_C)).reshape(ncb, kn)
    krow = np.broadcast_to(key_rows[:, :, None], (rows, wr, NA_KBLK_C)).reshape(rows, kn)
    qcol = cb[:, None] * NA_QBLK_C + np.arange(NA_QBLK_C)
    win0 = np.clip(qcol - NA_WIN_C // 2, 0, GRID_W - NA_WIN_C)
    valid = (kcol[:, None, :] >= win0[..., None]) & (kcol[:, None, :] < win0[..., None] + NA_WIN_C)
    dri = (krow - r[:, None] + NA_WIN_R - 1)[:, None, None, :]
    dci = np.clip(kcol[:, None, :] - qcol[..., None] + NA_WIN_C - 1, 0, 2 * NA_WIN_C - 2)[None]
    return kidx, valid, dri, dci


def neighbourhood_attention(q, k, v, k_ctx, v_ctx, rpb, scale):
    Bsz, T, H, d = q.shape
    rows = T // GRID_W
    ncb = GRID_W // NA_QBLK_C
    kidx, valid, dri, dci = na_block_indices(rows)
    qb = q.reshape(Bsz, rows, ncb, NA_QBLK_C, H, d)
    kb = jnp.take(k, kidx, axis=1)
    vb = jnp.take(v, kidx, axis=1)
    bias = rpb[:, dri, dci].astype(F32)
    s_win = jnp.einsum('brcqhd,brckhd->bhrcqk', qb, kb).astype(F32) * scale + bias
    s_win = jnp.where(valid, s_win, NEG_INF)
    s_ctx = jnp.einsum('brcqhd,bkhd->bhrcqk', qb, k_ctx).astype(F32) * scale
    p = jax.nn.softmax(jnp.concatenate([s_win, s_ctx], axis=-1), axis=-1).astype(v.dtype)
    kn = kidx.shape[-1]
    o = (jnp.einsum('bhrcqk,brckhd->brcqhd', p[..., :kn], vb)
         + jnp.einsum('bhrcqk,bkhd->brcqhd', p[..., kn:], v_ctx))
    return o.reshape(Bsz, T, H, d)


def na_branch(qkv, z, qkv_c, z_c, q_norm, k_norm, rpb):
    def prep(qkv):
        Bsz, T, _ = qkv.shape
        t = qkv.reshape(Bsz, T, 3, NA_HEADS, NA_DH)
        return rmsnorm(t[:, :, 0], q_norm), rmsnorm(t[:, :, 1], k_norm), t[:, :, 2]

    q, k, v = prep(qkv)
    qc, kc, vc = prep(qkv_c)
    scale = NA_DH ** -0.5
    o_lat = neighbourhood_attention(q, k, v, kc, vc, rpb, scale)
    o_ctx = softmax_attention(qc, kc, vc, scale)
    return (o_lat.reshape(z.shape) * jax.nn.silu(z), o_ctx.reshape(z_c.shape) * jax.nn.silu(z_c))


def mla_branch(cq, ckv, kr, z, cq_c, ckv_c, kr_c, z_c,
               qa_norm, w_uq, kva_norm, w_ukv, q_norm, k_norm):
    def project(cq, ckv, kr, positioned):
        Bsz, T, _ = cq.shape
        q = (rmsnorm(cq, qa_norm) @ w_uq).reshape(Bsz, T, MLA_HEADS, MLA_NOPE + MLA_ROPE)
        kv = (rmsnorm(ckv, kva_norm) @ w_ukv).reshape(Bsz, T, MLA_HEADS, MLA_NOPE + MLA_V)
        k_rope = jnp.broadcast_to(kr[:, :, None, :], (Bsz, T, MLA_HEADS, MLA_ROPE))
        k = jnp.concatenate([kv[..., :MLA_NOPE], k_rope], axis=-1)
        v = kv[..., MLA_NOPE:]
        q = rmsnorm(q, q_norm)
        k = rmsnorm(k, k_norm)
        if positioned:
            q = jnp.concatenate([q[..., :MLA_NOPE], axial_rope_2d(q[..., MLA_NOPE:])], axis=-1)
            k = jnp.concatenate([k[..., :MLA_NOPE], axial_rope_2d(k[..., MLA_NOPE:])], axis=-1)
        return q, k, v

    q, k, v = project(cq, ckv, kr, True)
    qc, kc, vc = project(cq_c, ckv_c, kr_c, False)
    scale = (MLA_NOPE + MLA_ROPE) ** -0.5
    o_lat = blocked_attention(q, jnp.concatenate([kc, k], axis=1), jnp.concatenate([vc, v], axis=1), scale)
    o_ctx = softmax_attention(qc, kc, vc, scale)
    return (o_lat.reshape(z.shape) * jax.nn.silu(z), o_ctx.reshape(z_c.shape) * jax.nn.silu(z_c))


def ssd_scan(xs, dt, A, Bm, Cm, h0):
    Bsz, T, H, P = xs.shape
    G, N = Bm.shape[2], Bm.shape[3]
    C = SSM_CHUNK
    nc = T // C
    Bh = jnp.repeat(Bm.astype(F32), H // G, axis=2).reshape(Bsz, nc, C, H, N)
    Ch = jnp.repeat(Cm.astype(F32), H // G, axis=2).reshape(Bsz, nc, C, H, N)
    xdt = (xs.astype(F32) * dt[..., None]).reshape(Bsz, nc, C, H, P)
    cum = jnp.cumsum((dt * A).reshape(Bsz, nc, C, H), axis=2)
    causal = np.tril(np.ones((C, C), bool))[:, :, None]
    seg = cum[:, :, :, None, :] - cum[:, :, None, :, :]
    L = jnp.where(causal, jnp.exp(jnp.where(causal, seg, 0.0)), 0.0)
    scores = jnp.einsum('bnqhs,bnkhs->bnqkh', Ch, Bh) * L
    y_diag = jnp.einsum('bnqkh,bnkhp->bnqhp', scores, xdt)
    decay_to_end = jnp.exp(cum[:, :, -1:, :] - cum)
    states = jnp.einsum('bnkhs,bnkh,bnkhp->bnhps', Bh, decay_to_end, xdt)
    chunk_decay = jnp.exp(cum[:, :, -1, :])

    def step(h, inp):
        st, dec = inp
        return h * dec[..., None, None] + st, h

    h_last, h_prev = lax.scan(step, h0, (jnp.moveaxis(states, 1, 0), jnp.moveaxis(chunk_decay, 1, 0)))
    y_off = jnp.einsum('bnqhs,nbhps,bnqh->bnqhp', Ch, h_prev, jnp.exp(cum))
    return (y_diag + y_off).reshape(Bsz, T, H, P), h_last


def ssd_branch(z, xbc, dt_in, z_c, xbc_c, dt_in_c, conv_w, conv_b, A_log, dt_bias, D_skip, norm_w):
    A = -jnp.exp(A_log.astype(F32))

    def prep(xbc, dt_in):
        Bsz, T, _ = xbc.shape
        xbc = jax.nn.silu(dwconv_centred(xbc, conv_w) + conv_b)
        xs = xbc[..., :SSM_W].reshape(Bsz, T, SSM_HEADS, SSM_HEADDIM)
        Bm = xbc[..., SSM_W:SSM_W + SSM_GROUPS * SSM_STATE].reshape(Bsz, T, SSM_GROUPS, SSM_STATE)
        Cm = xbc[..., SSM_W + SSM_GROUPS * SSM_STATE:].reshape(Bsz, T, SSM_GROUPS, SSM_STATE)
        dt = jax.nn.softplus(dt_in.astype(F32).reshape(Bsz, T, 2, SSM_HEADS) + dt_bias.astype(F32))
        return xs, Bm, Cm, dt

    def flip(t):
        return jnp.flip(t, axis=1)

    xl, Bl, Cl, dtl = prep(xbc, dt_in)
    xc, Bc, Cc, dtc = prep(xbc_c, dt_in_c)
    h0 = jnp.zeros((xc.shape[0], SSM_HEADS, SSM_HEADDIM, SSM_STATE), F32)
    yc_f, hc_f = ssd_scan(xc, dtc[:, :, 0], A[0], Bc, Cc, h0)
    yl_f, _ = ssd_scan(xl, dtl[:, :, 0], A[0], Bl, Cl, hc_f)
    yc_b, hc_b = ssd_scan(flip(xc), flip(dtc[:, :, 1]), A[1], flip(Bc), flip(Cc), h0)
    yl_b, _ = ssd_scan(flip(xl), flip(dtl[:, :, 1]), A[1], flip(Bl), flip(Cl), hc_b)

    def out(y_f, y_b, xs, z):
        Bsz, T = xs.shape[:2]
        y = y_f + flip(y_b) + D_skip.astype(F32)[:, None] * xs.astype(F32)
        y = y.reshape(Bsz, T, SSM_W).astype(z.dtype) * jax.nn.silu(z)
        return rmsnorm(y, norm_w)

    return out(yl_f, yl_b, xl, z), out(yc_f, yc_b, xc, z_c)


def hybrid_layer(x, ctx, c, c_ctx, norm_w, ada_w, ada_b, w_in,
                 gdn_conv_w, gdn_A_log, gdn_dt_bias, gdn_norm_w,
                 na_q_norm, na_k_norm, na_rpb,
                 mla_qa_norm, mla_w_uq, mla_kva_norm, mla_w_ukv, mla_q_norm, mla_k_norm,
                 ssm_conv_w, ssm_conv_b, ssm_A_log, ssm_dt_bias, ssm_D, ssm_norm_w, w_out):
    shift, scale, gate = jnp.split((jax.nn.silu(c) @ ada_w + ada_b)[:, None, :], 3, axis=-1)
    shift_c, scale_c, gate_c = jnp.split(jax.nn.silu(c_ctx) @ ada_w + ada_b, 3, axis=-1)
    h = rmsnorm(x, norm_w) * (1 + scale) + shift
    hc = rmsnorm(ctx, norm_w) * (1 + scale_c) + shift_c
    (g_qkv, g_z, g_beta, g_alpha, n_qkv, n_z, m_q, m_kv, m_kr, m_z, s_z, s_xbc, s_dt) = split_in(h @ w_in)
    (g_qkv_c, g_z_c, g_beta_c, g_alpha_c, n_qkv_c, n_z_c, m_q_c, m_kv_c, m_kr_c, m_z_c,
     s_z_c, s_xbc_c, s_dt_c) = split_in(hc @ w_in)
    oa, oa_c = gdn_branch(g_qkv, g_z, g_beta, g_alpha, g_qkv_c, g_z_c, g_beta_c, g_alpha_c,
                          gdn_conv_w, gdn_A_log, gdn_dt_bias, gdn_norm_w)
    ob, ob_c = na_branch(n_qkv, n_z, n_qkv_c, n_z_c, na_q_norm, na_k_norm, na_rpb)
    oc, oc_c = mla_branch(m_q, m_kv, m_kr, m_z, m_q_c, m_kv_c, m_kr_c, m_z_c,
                          mla_qa_norm, mla_w_uq, mla_kva_norm, mla_w_ukv, mla_q_norm, mla_k_norm)
    od, od_c = ssd_branch(s_z, s_xbc, s_dt, s_z_c, s_xbc_c, s_dt_c,
                          ssm_conv_w, ssm_conv_b, ssm_A_log, ssm_dt_bias, ssm_D, ssm_norm_w)
    y = jnp.concatenate([oa, ob, oc, od], axis=-1) @ w_out
    y_c = jnp.concatenate([oa_c, ob_c, oc_c, od_c], axis=-1) @ w_out
    return x + gate * y, ctx + gate_c * y_c


def setup_inputs(seed: int = 0) -> dict:
    key = jax.random.key(seed)
    ks = jax.random.split(key, 28)
    L = DEPTH

    def normal(k, shape, s):
        return jax.random.normal(k, shape, F32) * s

    def gain(k, shape):
        return 1.0 + 0.02 * jax.random.normal(k, shape, F32)

    def log_decay_init(k, shape):
        return jnp.log(jax.random.uniform(k, shape, F32, 1.0, 16.0))

    def dt_bias_init(k, shape):
        dt = jnp.exp(jax.random.uniform(k, shape, F32, math.log(1e-3), math.log(1e-1)))
        return dt + jnp.log(-jnp.expm1(-dt))

    return {
        'x': normal(ks[0], (BATCH, SEQ, D_MODEL), 1.0),
        'c': normal(ks[1], (BATCH, D_MODEL), 1.0),
        'ctx': normal(ks[2], (BATCH, CTX_LEN, D_MODEL), 1.0),
        'c_ctx': normal(ks[3], (D_MODEL,), 1.0),
        'norm_w': gain(ks[4], (L, D_MODEL)),
        'ada_w': normal(ks[5], (L, D_MODEL, 3 * D_MODEL), 0.3 * D_MODEL ** -0.5),
        'ada_b': normal(ks[6], (L, 3 * D_MODEL), 0.02),
        'w_in': normal(ks[7], (L, D_MODEL, D_IN), D_MODEL ** -0.5),
        'gdn_conv_w': normal(ks[8], (L, SHORT_CONV, 3 * GDN_W), SHORT_CONV ** -0.5),
        'gdn_A_log': log_decay_init(ks[9], (L, 2, GDN_HEADS)),
        'gdn_dt_bias': dt_bias_init(ks[10], (L, 2, GDN_HEADS)),
        'gdn_norm_w': gain(ks[11], (L, GDN_DV)),
        'na_q_norm': gain(ks[12], (L, NA_DH)),
        'na_k_norm': gain(ks[13], (L, NA_DH)),
        'na_rpb': normal(ks[14], (L, NA_HEADS, 2 * NA_WIN_R - 1, 2 * NA_WIN_C - 1), 0.1),
        'mla_qa_norm': gain(ks[15], (L, MLA_Q_RANK)),
        'mla_w_uq': normal(ks[16], (L, MLA_Q_RANK, MLA_HEADS * (MLA_NOPE + MLA_ROPE)), MLA_Q_RANK ** -0.5),
        'mla_kva_norm': gain(ks[17], (L, MLA_KV_RANK)),
        'mla_w_ukv': normal(ks[18], (L, MLA_KV_RANK, MLA_HEADS * (MLA_NOPE + MLA_V)), MLA_KV_RANK ** -0.5),
        'mla_q_norm': gain(ks[19], (L, MLA_NOPE + MLA_ROPE)),
        'mla_k_norm': gain(ks[20], (L, MLA_NOPE + MLA_ROPE)),
        'ssm_conv_w': normal(ks[21], (L, SHORT_CONV, SSM_CONV_DIM), SHORT_CONV ** -0.5),
        'ssm_conv_b': normal(ks[22], (L, SSM_CONV_DIM), 0.02),
        'ssm_A_log': log_decay_init(ks[23], (L, 2, SSM_HEADS)),
        'ssm_dt_bias': dt_bias_init(ks[24], (L, 2, SSM_HEADS)),
        'ssm_D': gain(ks[25], (L, SSM_HEADS)),
        'ssm_norm_w': gain(ks[26], (L, SSM_W)),
        'w_out': normal(ks[27], (L, D_MIX, D_MODEL), D_MIX ** -0.5),
    }


def reference(x, c, ctx, c_ctx, norm_w, ada_w, ada_b, w_in,
              gdn_conv_w, gdn_A_log, gdn_dt_bias, gdn_norm_w,
              na_q_norm, na_k_norm, na_rpb,
              mla_qa_norm, mla_w_uq, mla_kva_norm, mla_w_ukv, mla_q_norm, mla_k_norm,
              ssm_conv_w, ssm_conv_b, ssm_A_log, ssm_dt_bias, ssm_D, ssm_norm_w, w_out):
    for l in range(DEPTH):
        x, ctx = hybrid_layer(x, ctx, c, c_ctx, norm_w[l], ada_w[l], ada_b[l], w_in[l],
                              gdn_conv_w[l], gdn_A_log[l], gdn_dt_bias[l], gdn_norm_w[l],
                              na_q_norm[l], na_k_norm[l], na_rpb[l],
                              mla_qa_norm[l], mla_w_uq[l], mla_kva_norm[l], mla_w_ukv[l],
                              mla_q_norm[l], mla_k_norm[l],
                              ssm_conv_w[l], ssm_conv_b[l], ssm_A_log[l], ssm_dt_bias[l],
                              ssm_D[l], ssm_norm_w[l], w_out[l])
    return x
```

```cpp
#include <hip/hip_runtime.h>
#include <hip/hip_cooperative_groups.h>
#include <cstdio>
namespace cg = cooperative_groups;

typedef unsigned short bf16_t;
using bf16x8 = __attribute__((ext_vector_type(8))) short;
using f32x4 = __attribute__((ext_vector_type(4))) float;
using u32x4 = __attribute__((ext_vector_type(4))) unsigned;
using u32x2 = __attribute__((ext_vector_type(2))) unsigned;

#ifndef EN_GDN
#define EN_GDN 1
#endif
#ifndef EN_NA
#define EN_NA 1
#endif
#ifndef EN_MLA
#define EN_MLA 1
#endif
#ifndef EN_SSD
#define EN_SSD 1
#endif

constexpr int DM = 2048, NB = 4, TL = 4096, TC = 256, NL = 4;
constexpr int NTOK_L = NB * TL, NTOK_C = NB * TC, NTOK = NTOK_L + NTOK_C;
constexpr int DIN = 6880, DINP = 6912;
constexpr int C_GQKV = 0, C_GZ = 1536, C_GBETA = 2048, C_NQKV = 2064, C_NZ = 3600, C_MQ = 4112,
              C_MKV = 4496, C_MKR = 4752, C_MZ = 4816, C_SZ = 5328, C_SXBC = 5840, C_SDT = 6864;
constexpr int NCHUNK = 68;
constexpr int NGITEM = NB * 4 * 2 * NCHUNK;
constexpr float EPS = 1e-6f;

constexpr size_t al(size_t x) { return (x + 255) & ~(size_t)255; }
constexpr size_t OFF_WIN = 0;
constexpr size_t OFF_WOUT = OFF_WIN + al((size_t)NL * DINP * DM * 2);
constexpr size_t OFF_WUQ = OFF_WOUT + al((size_t)NL * DM * DM * 2);
constexpr size_t OFF_WUKV = OFF_WUQ + al((size_t)NL * 768 * 384 * 2);
constexpr size_t OFF_PM = OFF_WUKV + al((size_t)NL * 1024 * 256 * 2);
constexpr size_t OFF_MOD = OFF_PM + al((size_t)NL * 16 * 5 * 6144 * 4);
constexpr size_t OFF_H = OFF_MOD + al((size_t)NL * 5 * 6144 * 4);
constexpr size_t SZ_H = (size_t)NTOK * DM * 2;
constexpr size_t OFF_CQN = OFF_H;
constexpr size_t OFF_CKVN = OFF_CQN + al((size_t)NTOK * 384 * 2);
constexpr size_t OFF_QRAW = OFF_CKVN + al((size_t)NTOK * 256 * 2);
constexpr size_t OFF_KRAW = OFF_QRAW + al((size_t)NTOK * 768 * 2);
static_assert(OFF_KRAW + (size_t)NTOK * 512 * 2 <= OFF_H + SZ_H, "alias overflow");
constexpr size_t OFF_PROJ = OFF_H + al(SZ_H);
constexpr size_t OFF_PSM = OFF_PROJ + al((size_t)NTOK * DIN * 2);
constexpr size_t OFF_GQ = OFF_PSM + al((size_t)NTOK * 32 * 4);
constexpr size_t OFF_GK = OFF_GQ + al((size_t)NTOK * 512 * 2);
constexpr size_t OFF_GV = OFF_GK + al((size_t)NTOK * 512 * 2);
constexpr size_t OFF_GG = OFF_GV + al((size_t)NTOK * 512 * 2);
constexpr size_t OFF_GBETA = OFF_GG + al((size_t)2 * NTOK * 4 * 4);
constexpr size_t OFF_WNEG = OFF_GBETA + al((size_t)2 * NTOK * 4 * 4);
constexpr size_t OFF_U = OFF_WNEG + al((size_t)NGITEM * 64 * 128 * 2);
constexpr size_t OFF_QK = OFF_U + al((size_t)NGITEM * 64 * 128 * 2);
constexpr size_t OFF_GAM = OFF_QK + al((size_t)NGITEM * 64 * 64 * 2);
constexpr size_t OFF_GO = OFF_GAM + al((size_t)NGITEM * 64 * 4);
constexpr size_t OFF_NQ = OFF_GO + al((size_t)2 * NTOK * 512 * 2);
constexpr size_t OFF_NK = OFF_NQ + al((size_t)NTOK * 512 * 2);
constexpr size_t OFF_NVTL = OFF_NK + al((size_t)NTOK * 512 * 2);
constexpr size_t OFF_NVTC = OFF_NVTL + al((size_t)NB * 4 * 128 * TL * 2);
constexpr size_t OFF_MVTL = OFF_NVTC + al((size_t)NB * 4 * 128 * TC * 2);
constexpr size_t OFF_MVTC = OFF_MVTL + al((size_t)NB * 4 * 128 * TL * 2);
constexpr size_t OFF_MQ = OFF_MVTC + al((size_t)NB * 4 * 128 * TC * 2);
constexpr size_t OFF_MK = OFF_MQ + al((size_t)NTOK * 768 * 2);
constexpr size_t OFF_SX = OFF_MK + al((size_t)NTOK * 768 * 2);
constexpr size_t OFF_SB = OFF_SX + al((size_t)NTOK * 512 * 2);
constexpr size_t OFF_SC = OFF_SB + al((size_t)NTOK * 256 * 2);
constexpr size_t OFF_SDT = OFF_SC + al((size_t)NTOK * 256 * 2);
constexpr size_t OFF_SY = OFF_SDT + al((size_t)NTOK * 16 * 4);
constexpr size_t OFF_XC = OFF_SY + al((size_t)2 * NTOK * 512 * 2);
constexpr size_t OFF_TBL = OFF_XC + al((size_t)NTOK_C * DM * 4);
constexpr size_t OFF_WQ = OFF_TBL + 256;
constexpr size_t OFF_BAR = OFF_WQ + 1024;
constexpr size_t WS_END = OFF_BAR + 3456 * 4 + 256;

constexpr int LDS_BYTES = 79 * 1024;
constexpr int REP_INPROJ = 1, REP_MIX = 1, REP_SMALL = 1, REP_MLAUP = 1;

struct Params {
  const float* in[28];
  float* out;
  char* ws;
};

__device__ __forceinline__ float bf2f(bf16_t h) { return __uint_as_float(((unsigned)h) << 16); }
typedef __bf16 hwbf16x2 __attribute__((ext_vector_type(2)));
typedef float hwf32x2 __attribute__((ext_vector_type(2)));
__device__ __forceinline__ unsigned pack2(float a, float b) { hwf32x2 f = {a, b}; return __builtin_bit_cast(unsigned, __builtin_convertvector(f, hwbf16x2)); }
__device__ __forceinline__ bf16_t f2bf(float f) { return (bf16_t)(pack2(f, 0.f) & 0xffffu); }
__device__ __forceinline__ u32x2 pack4(f32x4 v) { return u32x2{pack2(v[0], v[1]), pack2(v[2], v[3])}; }
__device__ __forceinline__ float lo2f(unsigned u) { return __uint_as_float(u << 16); }
__device__ __forceinline__ float hi2f(unsigned u) { return __uint_as_float(u & 0xffff0000u); }
__device__ __forceinline__ float siluf(float x) { return x / (1.f + __expf(-x)); }
__device__ __forceinline__ float softplusf(float x) { return fmaxf(x, 0.f) + __logf(1.f + __expf(-fabsf(x))); }
template <int CTRL>
__device__ __forceinline__ float dpp_mov(float x) {
  return __builtin_bit_cast(float, __builtin_amdgcn_update_dpp(0, __builtin_bit_cast(int, x), CTRL, 0xf, 0xf, true));
}
__device__ __forceinline__ float lane_bcast(float v, int l) {
  return __builtin_bit_cast(float, __builtin_amdgcn_readlane(__builtin_bit_cast(int, v), l));
}
__device__ __forceinline__ float wave_sum(float v) {
  v += dpp_mov<0xB1>(v);
  v += dpp_mov<0x4E>(v);
  v += dpp_mov<0x141>(v);
  v += dpp_mov<0x140>(v);
  return (lane_bcast(v, 0) + lane_bcast(v, 16)) + (lane_bcast(v, 32) + lane_bcast(v, 48));
}
__device__ __forceinline__ float wave_incl_scan(float v, int lane) {
  v += dpp_mov<0x111>(v);
  v += dpp_mov<0x112>(v);
  v += dpp_mov<0x114>(v);
  v += dpp_mov<0x118>(v);
  const float t0 = lane_bcast(v, 15), t1 = lane_bcast(v, 31), t2 = lane_bcast(v, 47);
  return v + ((lane >= 16 ? t0 : 0.f) + (lane >= 32 ? t1 : 0.f) + (lane >= 48 ? t2 : 0.f));
}
__device__ __forceinline__ float xrow_max(float v) {
  unsigned u = __builtin_bit_cast(unsigned, v);
  auto a = __builtin_amdgcn_permlane16_swap(u, u, false, false);
  float m = fmaxf(__builtin_bit_cast(float, a[0]), __builtin_bit_cast(float, a[1]));
  unsigned um = __builtin_bit_cast(unsigned, m);
  auto b2 = __builtin_amdgcn_permlane32_swap(um, um, false, false);
  return fmaxf(__builtin_bit_cast(float, b2[0]), __builtin_bit_cast(float, b2[1]));
}
__device__ __forceinline__ f32x4 mfma16(bf16x8 a, bf16x8 b, f32x4 c) {
  return __builtin_amdgcn_mfma_f32_16x16x32_bf16(a, b, c, 0, 0, 0);
}
__device__ __forceinline__ bf16x8 ldsfrag(const bf16_t* p) { return *(const bf16x8*)p; }


__device__ __forceinline__ int bid_opaque() { int t = blockIdx.x; asm volatile("" : "+s"(t)); return t; }
__device__ __forceinline__ int tid_opaque() { int t = threadIdx.x; asm volatile("" : "+v"(t)); return t; }

__device__ __forceinline__ int first_item(int lo) { int g = (int)gridDim.x; int d = ((int)bid_opaque() - lo) % g; if (d < 0) d += g; return lo + d; }
__device__ __forceinline__ char* wsb(const Params& p) { return p.ws; }
__device__ __forceinline__ int wq_next(int* ctr, char* smem) {
  int* slot = (int*)(smem + LDS_BYTES - 16);
  __syncthreads();
  if (tid_opaque() == 0) *slot = atomicAdd(ctr, 1);
  __syncthreads();
  return __builtin_amdgcn_readfirstlane(*slot);
}

__device__ __forceinline__ const float* inp(const Params& p, int i) { return ((const float* const*)(wsb(p) + OFF_TBL))[i]; }

__device__ __forceinline__ void lds_barrier() { asm volatile("s_waitcnt lgkmcnt(0)\n\ts_barrier" ::: "memory"); }

__device__ __forceinline__ int tokmap(int v) { return (((v & 7) * (NTOK / 32)) + (v >> 3)) * 4; }

__device__ __forceinline__ void tok_decode(int tok, int& isc, int& b, int& t) {
  if (tok < NTOK_L) { isc = 0; b = tok >> 12; t = tok & 4095; }
  else { int c = tok - NTOK_L; isc = 1; b = c >> 8; t = c & 255; }
}
__device__ __forceinline__ int chain_tok(int b, int dir, int c, int i) {
  int pos = c * 64 + i;
  if (c < 4) { int t = dir ? (255 - pos) : pos; return NTOK_L + b * 256 + t; }
  int pl = pos - 256; int t = dir ? (4095 - pl) : pl; return b * 4096 + t;
}
__device__ __forceinline__ const float* xrow_src(const Params& p, int l, int tok) {
  if (tok < NTOK_L) return (l == 0 ? inp(p, 0) : p.out) + (size_t)tok * DM;
  return (l == 0 ? inp(p, 2) : (const float*)(wsb(p) + OFF_XC)) + (size_t)(tok - NTOK_L) * DM;
}
__device__ __forceinline__ float* xrow_dst(const Params& p, int tok) {
  if (tok < NTOK_L) return p.out + (size_t)tok * DM;
  return (float*)(wsb(p) + OFF_XC) + (size_t)(tok - NTOK_L) * DM;
}

__device__ __forceinline__ void gemm128(const bf16_t* __restrict__ A, int lda, const bf16_t* __restrict__ Bt, int ldb,
                                        int K, char* smem, f32x4 (&acc)[4][4]) {
  bf16_t* sb0 = (bf16_t*)smem;
  bf16_t* sb1 = sb0 + 2 * 128 * 72;
  const int tid = tid_opaque(), wave = tid >> 6, lane = tid & 63, r = lane & 15, q = lane >> 4;
  const int wr = wave >> 1, wc = wave & 1;
#pragma unroll
  for (int i = 0; i < 4; i++)
#pragma unroll
    for (int j = 0; j < 4; j++) acc[i][j] = f32x4{0.f, 0.f, 0.f, 0.f};
  u32x4 ra0[4], rb0[4], ra1[4], rb1[4];
  const int lrow = tid >> 3, lc8 = (tid & 7) * 8;
  const bf16_t* Ap = A + (size_t)lrow * lda + lc8;
  const bf16_t* Bp = Bt + (size_t)lrow * ldb + lc8;
#define G_LOAD(RA, RB, kt_)                                                         \
  _Pragma("unroll") for (int pz = 0; pz < 4; pz++) {                                \
    RA[pz] = *(const u32x4*)(Ap + (size_t)pz * 32 * lda + (kt_) * 64);              \
    RB[pz] = *(const u32x4*)(Bp + (size_t)pz * 32 * ldb + (kt_) * 64);              \
  }
#define G_STORE(SB, RA, RB)                                                         \
  _Pragma("unroll") for (int pz = 0; pz < 4; pz++) {                                \
    *(u32x4*)((SB) + (pz * 32 + lrow) * 72 + lc8) = RA[pz];                         \
    *(u32x4*)((SB) + 128 * 72 + (pz * 32 + lrow) * 72 + lc8) = RB[pz];              \
  }
#define G_COMPUTE(SB)                                                               \
  _Pragma("unroll") for (int ks = 0; ks < 2; ks++) {                                \
    bf16x8 a[4], b[4];                                                              \
    _Pragma("unroll") for (int i = 0; i < 4; i++) a[i] = ldsfrag((SB) + (wr * 64 + i * 16 + r) * 72 + ks * 32 + q * 8);            \
    _Pragma("unroll") for (int j = 0; j < 4; j++) b[j] = ldsfrag((SB) + 128 * 72 + (wc * 64 + j * 16 + r) * 72 + ks * 32 + q * 8); \
    _Pragma("unroll") for (int i = 0; i < 4; i++)                                   \
      _Pragma("unroll") for (int j = 0; j < 4; j++) acc[i][j] = mfma16(b[j], a[i], acc[i][j]); \
  }
  const int nk = K >> 6;
  G_LOAD(ra0, rb0, 0)
  G_LOAD(ra1, rb1, 1)
  G_STORE(sb0, ra0, rb0)
  G_LOAD(ra0, rb0, 2)
  lds_barrier();
  for (int kt = 0; kt < nk; kt += 2) {
    G_COMPUTE(sb0)
    G_STORE(sb1, ra1, rb1)
    if (kt + 3 < nk) { G_LOAD(ra1, rb1, kt + 3) }
    lds_barrier();
    G_COMPUTE(sb1)
    if (kt + 2 < nk) {
      G_STORE(sb0, ra0, rb0)
      if (kt + 4 < nk) { G_LOAD(ra0, rb0, kt + 4) }
    }
    lds_barrier();
  }
#undef G_LOAD
#undef G_STORE
#undef G_COMPUTE
}

__device__ __forceinline__ void ctile_stage_bf16(char* smem, const f32x4 (&acc)[4][4]) {
  bf16_t* Cs = (bf16_t*)smem;
  const int tid = tid_opaque(), wave = tid >> 6, lane = tid & 63, r = lane & 15, q = lane >> 4;
  const int wr = wave >> 1, wc = wave & 1;
#pragma unroll
  for (int i = 0; i < 4; i++)
#pragma unroll
    for (int j = 0; j < 4; j++)
      *(u32x2*)(Cs + (wr * 64 + i * 16 + r) * 136 + wc * 64 + j * 16 + q * 4) = pack4(acc[i][j]);
  lds_barrier();
}
__device__ __forceinline__ void ctile_store_rows(char* smem, bf16_t* __restrict__ dst, int ld, int ncols) {
  const bf16_t* Cs = (const bf16_t*)smem;
  const int tid = tid_opaque();
#pragma unroll
  for (int c = 0; c < 8; c++) {
    int ch = tid + 256 * c, row = ch >> 4, c8 = (ch & 15) * 8;
    if (c8 < ncols) *(u32x4*)(dst + (size_t)row * ld + c8) = *(const u32x4*)(Cs + row * 136 + c8);
  }
}
template <class F>
__device__ __forceinline__ void ctile_store_transposed(char* smem, F dstT) {
  const bf16_t* Cs = (const bf16_t*)smem;
  const int tid = tid_opaque();
#pragma unroll
  for (int c = 0; c < 8; c++) {
    int ch = tid + 256 * c, n = ch & 127, m8 = ch >> 7;
    bf16_t* d = dstT(n);
    if (d) {
      u32x4 v;
#pragma unroll
      for (int k = 0; k < 4; k++)
        v[k] = (unsigned)Cs[(m8 * 8 + 2 * k) * 136 + n] | ((unsigned)Cs[(m8 * 8 + 2 * k + 1) * 136 + n] << 16);
      *(u32x4*)(d + m8 * 8) = v;
    }
  }
}

__device__ __forceinline__ void gemm128x256(const bf16_t* __restrict__ A, int lda, const bf16_t* __restrict__ Bt, int ldb,
                                            int K, char* smem, f32x4 (&acc)[4][8]) {
  constexpr int STB = 384 * 64;
  const int tid = tid_opaque(), wave = tid >> 6, lane = tid & 63, r = lane & 15, q = lane >> 4;
  const int wr = wave >> 1, wc = wave & 1;
#pragma unroll
  for (int i = 0; i < 4; i++)
#pragma unroll
    for (int j = 0; j < 8; j++) acc[i][j] = f32x4{0.f, 0.f, 0.f, 0.f};
  const bf16_t* gsrc[6];
#pragma unroll
  for (int i = 0; i < 6; i++) {
    int row = (wave + 4 * i) * 16 + (lane >> 2);
    int c = (lane & 3) ^ ((row >> 2) & 3);
    gsrc[i] = (i < 2) ? A + (size_t)row * lda + c * 8 : Bt + (size_t)(row - 128) * ldb + c * 8;
  }
  const int ldsl = wave * 1024 + lane * 16;
#define D_ISSUE(kt_, ST)                                                              \
  {                                                                                   \
    char* sb_ = smem + (ST) * STB + ldsl;                                             \
    _Pragma("unroll") for (int i = 0; i < 6; i++)                                     \
      __builtin_amdgcn_global_load_lds((const unsigned*)(gsrc[i] + (kt_) * 32), (unsigned*)(sb_ + i * 4096), 16, 0, 0); \
  }
  const int nk = K >> 5;
  const int sw = (q ^ (r >> 2)) * 16;
  D_ISSUE(0, 0)
  D_ISSUE(1, 1)
  int st = 0;
  for (int kt = 0; kt < nk; kt++) {
    asm volatile("s_waitcnt vmcnt(6)" ::: "memory");
    lds_barrier();
    const char* sb = smem + st * STB;
    bf16x8 a[4], b[8];
#pragma unroll
    for (int i = 0; i < 4; i++) a[i] = *(const bf16x8*)(sb + (wr * 64 + i * 16 + r) * 64 + sw);
#pragma unroll
    for (int j = 0; j < 8; j++) b[j] = *(const bf16x8*)(sb + (128 + wc * 128 + j * 16 + r) * 64 + sw);
    __builtin_amdgcn_sched_barrier(0);
    {
      int st2 = st + 2; if (st2 >= 3) st2 -= 3;
      int kn = min(kt + 2, nk - 1);
      D_ISSUE(kn, st2)
    }
    __builtin_amdgcn_sched_barrier(0);
    __builtin_amdgcn_s_setprio(1);
#pragma unroll
    for (int i = 0; i < 4; i++)
#pragma unroll
      for (int j = 0; j < 8; j++) acc[i][j] = mfma16(b[j], a[i], acc[i][j]);
    __builtin_amdgcn_s_setprio(0);
    st = (st == 2) ? 0 : st + 1;
  }
#undef D_ISSUE
  asm volatile("s_waitcnt vmcnt(0)" ::: "memory");
  lds_barrier();
}
__device__ __forceinline__ void ctile256_stage_bf16(char* smem, const f32x4 (&acc)[4][8]) {
  bf16_t* Cs = (bf16_t*)smem;
  const int tid = tid_opaque(), wave = tid >> 6, lane = tid & 63, r = lane & 15, q = lane >> 4;
  const int wr = wave >> 1, wc = wave & 1;
#pragma unroll
  for (int i = 0; i < 4; i++)
#pragma unroll
    for (int j = 0; j < 8; j++)
      *(u32x2*)(Cs + (wr * 64 + i * 16 + r) * 264 + wc * 128 + j * 16 + q * 4) = pack4(acc[i][j]);
  lds_barrier();
}
__device__ __forceinline__ void ctile256_store_rows(char* smem, bf16_t* __restrict__ dst, int ld, int c0, int ncols) {
  const bf16_t* Cs = (const bf16_t*)smem;
  const int tid = tid_opaque();
#pragma unroll
  for (int c = 0; c < 16; c++) {
    int ch = tid + 256 * c, row = ch >> 5, c8 = (ch & 31) * 8;
    if (c8 >= c0 && c8 < c0 + ncols) *(u32x4*)(dst + (size_t)row * ld + c8) = *(const u32x4*)(Cs + row * 264 + c8);
  }
}
template <class F>
__device__ __forceinline__ void ctile256_store_transposed(char* smem, F dstT) {
  const bf16_t* Cs = (const bf16_t*)smem;
  const int tid = tid_opaque();
#pragma unroll
  for (int c = 0; c < 16; c++) {
    int ch = tid + 256 * c, n = ch & 255, m8 = ch >> 8;
    bf16_t* d = dstT(n);
    if (d) {
      u32x4 v;
#pragma unroll
      for (int k = 0; k < 4; k++)
        v[k] = (unsigned)Cs[(m8 * 8 + 2 * k) * 264 + n] | ((unsigned)Cs[(m8 * 8 + 2 * k + 1) * 264 + n] << 16);
      *(u32x4*)(d + m8 * 8) = v;
    }
  }
}

__device__ __forceinline__ void transpose_tile(const float* __restrict__ W, int K, int N, bf16_t* __restrict__ Wt, int k0, int n0, char* smem) {
  float* lds = (float*)smem;
  const int tid = tid_opaque();
  f32x4 v[16];
  const int n4 = (tid & 63) * 4;
#pragma unroll
  for (int i = 0; i < 16; i++) {
    int kk = i * 4 + (tid >> 6);
    v[i] = (n0 + n4 < N) ? *(const f32x4*)(W + (size_t)(k0 + kk) * N + n0 + n4) : f32x4{0.f, 0.f, 0.f, 0.f};
  }
#pragma unroll
  for (int i = 0; i < 16; i++) {
    int kk = i * 4 + (tid >> 6);
#pragma unroll
    for (int e = 0; e < 4; e++) lds[kk * 257 + n4 + e] = v[i][e];
  }
  __syncthreads();
  const int k8 = (tid & 7) * 8;
#pragma unroll
  for (int pz = 0; pz < 8; pz++) {
    int n = (tid >> 3) + 32 * pz;
    u32x4 o;
#pragma unroll
    for (int e = 0; e < 4; e++) o[e] = pack2(lds[(k8 + 2 * e) * 257 + n], lds[(k8 + 2 * e + 1) * 257 + n]);
    *(u32x4*)(Wt + (size_t)(n0 + n) * K + k0 + k8) = o;
  }
  __syncthreads();
}

__device__ __forceinline__ void phase0(const Params& p, char* smem) {
  constexpr int N_A = NL * 32 * 27, N_B = NL * 32 * 8, N_C = NL * 6 * 3, N_D = NL * 4 * 4, N_E = NL * 24 * 16;
  constexpr int NT = N_A + N_B + N_C + N_D + N_E;
  for (int it = bid_opaque(); it < NT; it += gridDim.x) {
    int i = it;
    if (i < N_A) {
      int l = i / (32 * 27), rem = i % (32 * 27), kt = rem / 27, nt = rem % 27;
      transpose_tile(inp(p, 7) + (size_t)l * DM * DIN, DM, DIN, (bf16_t*)(wsb(p) + OFF_WIN) + (size_t)l * DINP * DM, kt * 64, nt * 256, smem);
      continue;
    }
    i -= N_A;
    if (i < N_B) {
      int l = i / 256, rem = i % 256, kt = rem / 8, nt = rem % 8;
      transpose_tile(inp(p, 27) + (size_t)l * DM * DM, DM, DM, (bf16_t*)(wsb(p) + OFF_WOUT) + (size_t)l * DM * DM, kt * 64, nt * 256, smem);
      continue;
    }
    i -= N_B;
    if (i < N_C) {
      int l = i / 18, rem = i % 18, kt = rem / 3, nt = rem % 3;
      transpose_tile(inp(p, 16) + (size_t)l * 384 * 768, 384, 768, (bf16_t*)(wsb(p) + OFF_WUQ) + (size_t)l * 768 * 384, kt * 64, nt * 256, smem);
      continue;
    }
    i -= N_C;
    if (i < N_D) {
      int l = i / 16, rem = i % 16, kt = rem / 4, nt = rem % 4;
      transpose_tile(inp(p, 18) + (size_t)l * 256 * 1024, 256, 1024, (bf16_t*)(wsb(p) + OFF_WUKV) + (size_t)l * 1024 * 256, kt * 64, nt * 256, smem);
      continue;
    }
    i -= N_D;
    {
      int l = i / (24 * 16), rem = i % (24 * 16), jb = rem / 16, ks = rem % 16;
      float* sc = (float*)smem;
      const int tid = tid_opaque();
      for (int e = tid; e < 5 * 128; e += 256) {
        int rr = e >> 7, k = e & 127;
        float cv = (rr < 4) ? inp(p, 1)[rr * DM + ks * 128 + k] : inp(p, 3)[ks * 128 + k];
        sc[e] = siluf(cv);
      }
      __syncthreads();
      const float* w = inp(p, 5) + (size_t)l * DM * 6144 + (size_t)(ks * 128) * 6144 + jb * 256 + tid;
      float a0 = 0, a1 = 0, a2 = 0, a3 = 0, a4 = 0;
#pragma unroll 16
      for (int k = 0; k < 128; k++) {
        float wv = w[(size_t)k * 6144];
        a0 += sc[k] * wv; a1 += sc[128 + k] * wv; a2 += sc[256 + k] * wv; a3 += sc[384 + k] * wv; a4 += sc[512 + k] * wv;
      }
      float* pm = (float*)(wsb(p) + OFF_PM) + (size_t)((l * 16 + ks) * 5) * 6144 + jb * 256 + tid;
      pm[0] = a0; pm[6144] = a1; pm[2 * 6144] = a2; pm[3 * 6144] = a3; pm[4 * 6144] = a4;
      __syncthreads();
    }
  }
}

__device__ __forceinline__ void phase_modred(const Params& p) {
  const int n = NL * 5 * 6144;
  for (int i = bid_opaque() * 256 + tid_opaque(); i < n; i += gridDim.x * 256) {
    int l = i / (5 * 6144), rem = i % (5 * 6144), rr = rem / 6144, j = rem % 6144;
    float s = inp(p, 6)[l * 6144 + j];
    const float* pm = (const float*)(wsb(p) + OFF_PM) + (size_t)(l * 16 * 5 + rr) * 6144 + j;
#pragma unroll
    for (int ks = 0; ks < 16; ks++) s += pm[(size_t)ks * 5 * 6144];
    ((float*)(wsb(p) + OFF_MOD))[i] = s;
  }
}

__device__ __forceinline__ void phase_norm(const Params& p, int l) {
  const int wave = tid_opaque() >> 6, lane = tid_opaque() & 63;
  bf16_t* H = (bf16_t*)(wsb(p) + OFF_H);
  const float* nw = inp(p, 4) + l * DM;
  const int nit = NTOK / 4, gstep = gridDim.x;
  f32x4 w4[8];
#pragma unroll
  for (int i = 0; i < 8; i++) w4[i] = *(const f32x4*)(nw + (lane + 64 * i) * 4);
  f32x4 v[8], nv[8];
  int it = bid_opaque();
  if (it < nit) {
    const f32x4* src = (const f32x4*)xrow_src(p, l, it * 4 + wave);
#pragma unroll
    for (int i = 0; i < 8; i++) v[i] = src[lane + 64 * i];
  }
  for (; it < nit; it += gstep) {
    const int tok = it * 4 + wave;
    const bool more = it + gstep < nit;
    if (more) {
      const f32x4* src = (const f32x4*)xrow_src(p, l, (it + gstep) * 4 + wave);
#pragma unroll
      for (int i = 0; i < 8; i++) nv[i] = src[lane + 64 * i];
    }
    int isc, b, t; tok_decode(tok, isc, b, t);
    const float* mod = (const float*)(wsb(p) + OFF_MOD) + (size_t)(l * 5 + (isc ? 4 : b)) * 6144;
    f32x4 sh[8], sc[8];
#pragma unroll
    for (int i = 0; i < 8; i++) {
      int col = (lane + 64 * i) * 4;
      sh[i] = *(const f32x4*)(mod + col);
      sc[i] = *(const f32x4*)(mod + 2048 + col);
    }
    float ss = 0.f;
#pragma unroll
    for (int i = 0; i < 8; i++) ss += v[i][0] * v[i][0] + v[i][1] * v[i][1] + v[i][2] * v[i][2] + v[i][3] * v[i][3];
    ss = wave_sum(ss);
    float rstd = rsqrtf(ss * (1.f / DM) + EPS);
#pragma unroll
    for (int i = 0; i < 8; i++) {
      int col = (lane + 64 * i) * 4;
      f32x4 o = v[i] * rstd * w4[i] * (sc[i] + 1.f) + sh[i];
      *(u32x2*)(H + (size_t)tok * DM + col) = pack4(o);
    }
    if (more) {
#pragma unroll
      for (int i = 0; i < 8; i++) v[i] = nv[i];
    }
  }
}

__device__ __forceinline__ void phase_inproj(const Params& p, int l, char* smem) {
  const bf16_t* H = (const bf16_t*)(wsb(p) + OFF_H);
  const bf16_t* W = (const bf16_t*)(wsb(p) + OFF_WIN) + (size_t)l * DINP * DM;
  bf16_t* PROJ = (bf16_t*)(wsb(p) + OFF_PROJ);
  float* PSM = (float*)(wsb(p) + OFF_PSM);
  bf16_t* NVTL = (bf16_t*)(wsb(p) + OFF_NVTL);
  bf16_t* NVTC = (bf16_t*)(wsb(p) + OFF_NVTC);
  const int xcd = bid_opaque() & 7, lb = bid_opaque() >> 3, nlb = (int)gridDim.x >> 3;
  const int ntot = 17 * 27, nbig = (ntot / nlb) * nlb;
  for (int j = lb; j < nbig; j += nlb) {
    int mi, nt;
    { int g = j / 51, rem = j - g * 51; mi = rem / 3; nt = g * 3 + (rem - mi * 3); }
    int mt = xcd + 8 * mi;
    int m0 = mt * 128, n0 = nt * 256;
    int isc, b, t0; tok_decode(m0, isc, b, t0);
    f32x4 acc[4][8];
    gemm128x256(H + (size_t)m0 * DM, DM, W + (size_t)n0 * DM, DM, DM, smem, acc);
    if (nt == 8 || nt == 26) {
      const int tid = tid_opaque(), wave = tid >> 6, lane = tid & 63, r = lane & 15, q = lane >> 4;
      const int wr = wave >> 1, wc = wave & 1;
      const int cbase = (nt == 8) ? C_GBETA : C_SDT, pofs = (nt == 8) ? 0 : 16;
#pragma unroll
      for (int i = 0; i < 4; i++)
#pragma unroll
        for (int j2 = 0; j2 < 8; j2++)
#pragma unroll
          for (int e = 0; e < 4; e++) {
            int gcol = n0 + wc * 128 + j2 * 16 + q * 4 + e;
            if (gcol >= cbase && gcol < cbase + 16) PSM[(size_t)(m0 + wr * 64 + i * 16 + r) * 32 + pofs + gcol - cbase] = acc[i][j2][e];
          }
    }
    ctile256_stage_bf16(smem, acc);
    ctile256_store_rows(smem, PROJ + (size_t)m0 * DIN + n0, DIN, 0, min(256, DIN - n0));
    if (nt >= 12 && nt <= 14) {
      ctile256_store_transposed(smem, [&](int n) -> bf16_t* {
        int gcol = n0 + n;
        if (gcol < C_NQKV + 1024 || gcol >= C_NQKV + 1536) return nullptr;
        int hh = (gcol - (C_NQKV + 1024)) >> 7, d = (gcol - (C_NQKV + 1024)) & 127;
        return isc ? NVTC + ((size_t)((b * 4 + hh) * 128 + d)) * TC + t0 : NVTL + ((size_t)((b * 4 + hh) * 128 + d)) * TL + t0;
      });
    }
    __syncthreads();
  }
  for (int sidx = lb; sidx < (ntot - nbig) * 2; sidx += nlb) {
    int j = nbig + (sidx >> 1), hf2 = sidx & 1;
    int mi, nt;
    { int g = j / 51, rem = j - g * 51; mi = rem / 3; nt = g * 3 + (rem - mi * 3); }
    int mt = xcd + 8 * mi;
    int m0 = mt * 128, n0 = nt * 256 + hf2 * 128;
    f32x4 acc[4][4];
    gemm128(H + (size_t)m0 * DM, DM, W + (size_t)n0 * DM, DM, DM, smem, acc);
    if (n0 <= C_SDT && C_SDT < n0 + 128) {
      const int tid = tid_opaque(), wave = tid >> 6, lane = tid & 63, r = lane & 15, q = lane >> 4;
      const int wr = wave >> 1, wc = wave & 1;
#pragma unroll
      for (int i = 0; i < 4; i++)
#pragma unroll
        for (int j2 = 0; j2 < 4; j2++)
#pragma unroll
          for (int e = 0; e < 4; e++) {
            int gcol = n0 + wc * 64 + j2 * 16 + q * 4 + e;
            if (gcol >= C_SDT && gcol < C_SDT + 16) PSM[(size_t)(m0 + wr * 64 + i * 16 + r) * 32 + 16 + gcol - C_SDT] = acc[i][j2][e];
          }
    }
    ctile_stage_bf16(smem, acc);
    if (n0 < DIN) ctile_store_rows(smem, PROJ + (size_t)m0 * DIN + n0, DIN, min(128, DIN - n0));
    __syncthreads();
  }
}

__device__ __forceinline__ void phase_prep(const Params& p, int l) {
  const int wave = tid_opaque() >> 6, lane = tid_opaque() & 63;
  const bf16_t* PROJ = (const bf16_t*)(wsb(p) + OFF_PROJ);
  const float* PSM = (const float*)(wsb(p) + OFF_PSM);
  const int nit = NTOK / 4, gstep = gridDim.x;
  {
    bf16_t* GQ = (bf16_t*)(wsb(p) + OFF_GQ);
    bf16_t* GK = (bf16_t*)(wsb(p) + OFF_GK);
    bf16_t* GV = (bf16_t*)(wsb(p) + OFF_GV);
    float* GG = (float*)(wsb(p) + OFF_GG);
    float* GBETA = (float*)(wsb(p) + OFF_GBETA);
    const float* gcw = inp(p, 8) + (size_t)l * 3 * 1536;
    float2 w0[12], w1[12], w2[12];
#pragma unroll
    for (int wh = 0; wh < 12; wh++) {
      int c = (wh >> 2) * 512 + (wh & 3) * 128 + lane * 2;
      w0[wh] = *(const float2*)(gcw + c); w1[wh] = *(const float2*)(gcw + 1536 + c); w2[wh] = *(const float2*)(gcw + 3072 + c);
    }
    const float alog = (lane < 8) ? inp(p, 9)[l * 8 + lane] : 0.f;
    const float dtb = (lane < 8) ? inp(p, 10)[l * 8 + lane] : 0.f;
    unsigned g0[12], g1[12], g2[12], n0[12], n1[12], n2[12];
    float bi = 0.f, ai = 0.f, nbi = 0.f, nai = 0.f;
#define PREP1_LOAD(TOK, A0, A1, A2, BI, AI)                                                      \
    {                                                                                            \
      int isc_, b_, t_; tok_decode((TOK), isc_, b_, t_);                                         \
      const bf16_t* P0 = PROJ + (size_t)(TOK) * DIN;                                             \
      const bool hasm = t_ > 0, hasp = t_ < (isc_ ? TC : TL) - 1;                                \
      _Pragma("unroll") for (int wh = 0; wh < 12; wh++) {                                        \
        int c = (wh >> 2) * 512 + (wh & 3) * 128 + lane * 2;                                     \
        A1[wh] = *(const unsigned*)(P0 + C_GQKV + c);                                            \
        A0[wh] = hasm ? *(const unsigned*)(P0 - DIN + C_GQKV + c) : 0u;                          \
        A2[wh] = hasp ? *(const unsigned*)(P0 + DIN + C_GQKV + c) : 0u;                          \
      }                                                                                          \
      if (lane < 8) { BI = PSM[(size_t)(TOK) * 32 + lane]; AI = PSM[(size_t)(TOK) * 32 + 8 + lane]; } \
    }
    int it = bid_opaque();
    if (it < nit) PREP1_LOAD(tokmap(it) + wave, g0, g1, g2, bi, ai)
    for (; it < nit; it += gstep) {
      const int tok = tokmap(it) + wave;
      const bool more = it + gstep < nit;
      if (more) PREP1_LOAD(tokmap(it + gstep) + wave, n0, n1, n2, nbi, nai)
#pragma unroll
      for (int wh = 0; wh < 12; wh++) {
        int which = wh >> 2, h = wh & 3;
        float ya = siluf(w0[wh].x * lo2f(g0[wh]) + w1[wh].x * lo2f(g1[wh]) + w2[wh].x * lo2f(g2[wh]));
        float yb = siluf(w0[wh].y * hi2f(g0[wh]) + w1[wh].y * hi2f(g1[wh]) + w2[wh].y * hi2f(g2[wh]));
        if (which < 2) {
          float ss = wave_sum(ya * ya + yb * yb);
          float rn = rsqrtf(ss + EPS);
          if (which == 0) rn *= 0.08838834764831845f;
          ya *= rn; yb *= rn;
        }
        bf16_t* dst = (which == 0 ? GQ : (which == 1 ? GK : GV)) + (size_t)tok * 512 + h * 128 + lane * 2;
        *(unsigned*)dst = pack2(ya, yb);
      }
      if (lane < 8) {
        int dir = lane >> 2, h = lane & 3;
        float beta = 1.f / (1.f + __expf(-bi));
        float g = -__expf(alog) * softplusf(ai + dtb);
        GBETA[((size_t)dir * NTOK + tok) * 4 + h] = beta;
        GG[((size_t)dir * NTOK + tok) * 4 + h] = g;
      }
      if (more) {
#pragma unroll
        for (int wh = 0; wh < 12; wh++) { g0[wh] = n0[wh]; g1[wh] = n1[wh]; g2[wh] = n2[wh]; }
        bi = nbi; ai = nai;
      }
    }
#undef PREP1_LOAD
  }
  {
    bf16_t* NQ = (bf16_t*)(wsb(p) + OFF_NQ);
    bf16_t* NK = (bf16_t*)(wsb(p) + OFF_NK);
    bf16_t* CQN = (bf16_t*)(wsb(p) + OFF_CQN);
    bf16_t* CKVN = (bf16_t*)(wsb(p) + OFF_CKVN);
    const float2 nwq = *(const float2*)(inp(p, 12) + l * 128 + lane * 2);
    const float2 nwk = *(const float2*)(inp(p, 13) + l * 128 + lane * 2);
    float2 qaw[3], kvw[2];
#pragma unroll
    for (int i = 0; i < 3; i++) qaw[i] = *(const float2*)(inp(p, 15) + l * 384 + lane * 2 + 128 * i);
#pragma unroll
    for (int i = 0; i < 2; i++) kvw[i] = *(const float2*)(inp(p, 17) + l * 256 + lane * 2 + 128 * i);
    unsigned cu[13], nu[13];
#define PREP2_LOAD(TOK, U)                                                                       \
    {                                                                                            \
      const bf16_t* P0 = PROJ + (size_t)(TOK) * DIN;                                             \
      _Pragma("unroll") for (int wh = 0; wh < 8; wh++) U[wh] = *(const unsigned*)(P0 + C_NQKV + (wh >> 2) * 512 + (wh & 3) * 128 + lane * 2); \
      _Pragma("unroll") for (int i = 0; i < 3; i++) U[8 + i] = *(const unsigned*)(P0 + C_MQ + lane * 2 + 128 * i);   \
      _Pragma("unroll") for (int i = 0; i < 2; i++) U[11 + i] = *(const unsigned*)(P0 + C_MKV + lane * 2 + 128 * i); \
    }
    int it = bid_opaque();
    if (it < nit) PREP2_LOAD(tokmap(it) + wave, cu)
    for (; it < nit; it += gstep) {
      const int tok = tokmap(it) + wave;
      const bool more = it + gstep < nit;
      if (more) PREP2_LOAD(tokmap(it + gstep) + wave, nu)
#pragma unroll
      for (int wh = 0; wh < 8; wh++) {
        int which = wh >> 2, h = wh & 3;
        float xa = lo2f(cu[wh]), xb = hi2f(cu[wh]);
        float ss = wave_sum(xa * xa + xb * xb);
        float rn = rsqrtf(ss * (1.f / 128.f) + EPS);
        float2 nw = which ? nwk : nwq;
        bf16_t* dst = (which == 0 ? NQ : NK) + (size_t)tok * 512 + h * 128 + lane * 2;
        *(unsigned*)dst = pack2(xa * rn * nw.x, xb * rn * nw.y);
      }
      {
        float ss = 0.f;
#pragma unroll
        for (int i = 0; i < 3; i++) { float xa = lo2f(cu[8 + i]), xb = hi2f(cu[8 + i]); ss += xa * xa + xb * xb; }
        ss = wave_sum(ss);
        float rn = rsqrtf(ss * (1.f / 384.f) + EPS);
#pragma unroll
        for (int i = 0; i < 3; i++)
          *(unsigned*)(CQN + (size_t)tok * 384 + lane * 2 + 128 * i) = pack2(lo2f(cu[8 + i]) * rn * qaw[i].x, hi2f(cu[8 + i]) * rn * qaw[i].y);
      }
      {
        float ss = 0.f;
#pragma unroll
        for (int i = 0; i < 2; i++) { float xa = lo2f(cu[11 + i]), xb = hi2f(cu[11 + i]); ss += xa * xa + xb * xb; }
        ss = wave_sum(ss);
        float rn = rsqrtf(ss * (1.f / 256.f) + EPS);
#pragma unroll
        for (int i = 0; i < 2; i++)
          *(unsigned*)(CKVN + (size_t)tok * 256 + lane * 2 + 128 * i) = pack2(lo2f(cu[11 + i]) * rn * kvw[i].x, hi2f(cu[11 + i]) * rn * kvw[i].y);
      }
      if (more) {
#pragma unroll
        for (int i = 0; i < 13; i++) cu[i] = nu[i];
      }
    }
#undef PREP2_LOAD
  }
  {
    bf16_t* SX = (bf16_t*)(wsb(p) + OFF_SX);
    bf16_t* SB = (bf16_t*)(wsb(p) + OFF_SB);
    bf16_t* SC = (bf16_t*)(wsb(p) + OFF_SC);
    float* SDT = (float*)(wsb(p) + OFF_SDT);
    const float* scw = inp(p, 21) + (size_t)l * 3 * 1024;
    const float* scb = inp(p, 22) + (size_t)l * 1024;
    float2 w0[8], w1[8], w2[8], bb[8];
#pragma unroll
    for (int i = 0; i < 8; i++) {
      int c = lane * 2 + 128 * i;
      w0[i] = *(const float2*)(scw + c); w1[i] = *(const float2*)(scw + 1024 + c); w2[i] = *(const float2*)(scw + 2048 + c);
      bb[i] = *(const float2*)(scb + c);
    }
    const float dtb = (lane < 16) ? inp(p, 24)[l * 16 + lane] : 0.f;
    unsigned s0[8], s1[8], s2[8], n0[8], n1[8], n2[8];
    float dti = 0.f, ndti = 0.f;
#define PREP3_LOAD(TOK, A0, A1, A2, DTI)                                                         \
    {                                                                                            \
      int isc_, b_, t_; tok_decode((TOK), isc_, b_, t_);                                         \
      const bf16_t* P0 = PROJ + (size_t)(TOK) * DIN;                                             \
      const bool hasm = t_ > 0, hasp = t_ < (isc_ ? TC : TL) - 1;                                \
      _Pragma("unroll") for (int i = 0; i < 8; i++) {                                            \
        int c = lane * 2 + 128 * i;                                                              \
        A1[i] = *(const unsigned*)(P0 + C_SXBC + c);                                             \
        A0[i] = hasm ? *(const unsigned*)(P0 - DIN + C_SXBC + c) : 0u;                           \
        A2[i] = hasp ? *(const unsigned*)(P0 + DIN + C_SXBC + c) : 0u;                           \
      }                                                                                          \
      if (lane < 16) DTI = PSM[(size_t)(TOK) * 32 + 16 + lane];                                  \
    }
    int it = bid_opaque();
    if (it < nit) PREP3_LOAD(tokmap(it) + wave, s0, s1, s2, dti)
    for (; it < nit; it += gstep) {
      const int tok = tokmap(it) + wave;
      const bool more = it + gstep < nit;
      if (more) PREP3_LOAD(tokmap(it + gstep) + wave, n0, n1, n2, ndti)
#pragma unroll
      for (int i = 0; i < 8; i++) {
        int c = lane * 2 + 128 * i;
        float ya = siluf(w0[i].x * lo2f(s0[i]) + w1[i].x * lo2f(s1[i]) + w2[i].x * lo2f(s2[i]) + bb[i].x);
        float yb = siluf(w0[i].y * hi2f(s0[i]) + w1[i].y * hi2f(s1[i]) + w2[i].y * hi2f(s2[i]) + bb[i].y);
        bf16_t* dst = (i < 4) ? SX + (size_t)tok * 512 + c : (i < 6 ? SB + (size_t)tok * 256 + (c - 512) : SC + (size_t)tok * 256 + (c - 768));
        *(unsigned*)dst = pack2(ya, yb);
      }
      if (lane < 16) SDT[(size_t)tok * 16 + lane] = softplusf(dti + dtb);
      if (more) {
#pragma unroll
        for (int i = 0; i < 8; i++) { s0[i] = n0[i]; s1[i] = n1[i]; s2[i] = n2[i]; }
        dti = ndti;
      }
    }
#undef PREP3_LOAD
  }
}

__device__ __forceinline__ void gdn_chunk_prep(const Params& p, int item, char* smem) {
  bf16_t* Kl = (bf16_t*)smem;
  bf16_t* Ql = Kl + 64 * 136;
  bf16_t* VbT = (bf16_t*)smem;
  bf16_t* KbT = VbT + 128 * 72;
  float* Af = (float*)(smem + 36864);
  bf16_t* Tb = (bf16_t*)Af;
  float* Tf = Af + 64 * 68;
  float* Mt = Tf + 64 * 68;
  float* gaml = Mt + 768;
  float* betal = gaml + 64;
  const int tid = tid_opaque(), wave = tid >> 6, lane = tid & 63, r = lane & 15, q = lane >> 4;
  const int c = item % NCHUNK, dir = (item / NCHUNK) & 1, h = (item / (NCHUNK * 2)) & 3, b = item / (NCHUNK * 8);
  const bf16_t* GQ = (const bf16_t*)(wsb(p) + OFF_GQ);
  const bf16_t* GK = (const bf16_t*)(wsb(p) + OFF_GK);
  const bf16_t* GV = (const bf16_t*)(wsb(p) + OFF_GV);
  const float* GG = (const float*)(wsb(p) + OFF_GG);
  const float* GBETA = (const float*)(wsb(p) + OFF_GBETA);
#pragma unroll
  for (int i = 0; i < 4; i++) {
    int ch = tid + 256 * i, row = ch >> 4, c8 = (ch & 15) * 8;
    int tok = chain_tok(b, dir, c, row);
    size_t go = (size_t)tok * 512 + h * 128 + c8;
    *(u32x4*)(Kl + row * 136 + c8) = *(const u32x4*)(GK + go);
    *(u32x4*)(Ql + row * 136 + c8) = *(const u32x4*)(GQ + go);
  }
  if (wave == 0) {
    int tok = chain_tok(b, dir, c, lane);
    float g = GG[((size_t)dir * NTOK + tok) * 4 + h];
    float be = GBETA[((size_t)dir * NTOK + tok) * 4 + h];
    float gm = wave_incl_scan(g, lane);
    gaml[lane] = gm; betal[lane] = be;
    ((float*)(wsb(p) + OFF_GAM))[(size_t)item * 64 + lane] = gm;
  }
  __syncthreads();
  {
    f32x4 akk[4], aqk[4];
#pragma unroll
    for (int nt = 0; nt < 4; nt++) { akk[nt] = f32x4{0, 0, 0, 0}; aqk[nt] = f32x4{0, 0, 0, 0}; }
#pragma unroll
    for (int ks = 0; ks < 4; ks++) {
      bf16x8 aK = ldsfrag(Kl + (wave * 16 + r) * 136 + ks * 32 + q * 8);
      bf16x8 aQ = ldsfrag(Ql + (wave * 16 + r) * 136 + ks * 32 + q * 8);
#pragma unroll
      for (int nt = 0; nt < 4; nt++) {
        bf16x8 bK = ldsfrag(Kl + (nt * 16 + r) * 136 + ks * 32 + q * 8);
        akk[nt] = mfma16(aK, bK, akk[nt]);
        aqk[nt] = mfma16(aQ, bK, aqk[nt]);
      }
    }
    bf16_t* QKo = (bf16_t*)(wsb(p) + OFF_QK) + (size_t)item * 4096;
#pragma unroll
    for (int nt = 0; nt < 4; nt++)
#pragma unroll
      for (int e = 0; e < 4; e++) {
        int i = wave * 16 + q * 4 + e, j = nt * 16 + r;
        float dec = (j <= i) ? __expf(gaml[i] - gaml[j]) : 0.f;
        Af[i * 68 + j] = (j < i) ? betal[i] * akk[nt][e] * dec : 0.f;
        QKo[i * 64 + j] = f2bf(aqk[nt][e] * dec);
      }
  }
  __syncthreads();
  {
    int tok = chain_tok(b, dir, c, lane);
    float fv = betal[lane], fk = fv * __expf(gaml[lane]);
    const bf16_t* ks_ = GK + (size_t)tok * 512 + h * 128 + wave * 32;
    const bf16_t* vs_ = GV + (size_t)tok * 512 + h * 128 + wave * 32;
#pragma unroll
    for (int i = 0; i < 4; i++) {
      u32x4 kv = *(const u32x4*)(ks_ + i * 8);
      u32x4 vv = *(const u32x4*)(vs_ + i * 8);
      int d0 = wave * 32 + i * 8;
#pragma unroll
      for (int e = 0; e < 4; e++) {
        unsigned pkk = pack2(lo2f(kv[e]) * fk, hi2f(kv[e]) * fk), pkv = pack2(lo2f(vv[e]) * fv, hi2f(vv[e]) * fv);
        KbT[(d0 + 2 * e) * 72 + lane] = (bf16_t)pkk; KbT[(d0 + 2 * e + 1) * 72 + lane] = (bf16_t)(pkk >> 16);
        VbT[(d0 + 2 * e) * 72 + lane] = (bf16_t)pkv; VbT[(d0 + 2 * e + 1) * 72 + lane] = (bf16_t)(pkv >> 16);
      }
    }
  }
  if (tid < 64) {
    int blk = tid >> 4, cc = tid & 15;
    float x[16];
#pragma unroll
    for (int i = 0; i < 16; i++) {
      float acc = (i == cc) ? 1.f : 0.f;
#pragma unroll
      for (int j = 0; j < i; j++) acc -= Af[(16 * blk + i) * 68 + 16 * blk + j] * x[j];
      x[i] = acc;
    }
#pragma unroll
    for (int i = 0; i < 16; i++) Tf[(16 * blk + i) * 68 + 16 * blk + cc] = x[i];
  }
  __syncthreads();
  {
    const int rr = tid >> 4, cc = tid & 15;
#pragma unroll 1
    for (int d = 1; d < 4; d++) {
      for (int bi = 0; bi < 4 - d; bi++) {
        int i = d + bi, j = bi;
        float m = 0.f;
        for (int k = j; k < i; k++)
#pragma unroll
          for (int mm = 0; mm < 16; mm++) m += Af[(16 * i + rr) * 68 + 16 * k + mm] * Tf[(16 * k + mm) * 68 + 16 * j + cc];
        Mt[bi * 256 + rr * 16 + cc] = m;
      }
      __syncthreads();
      for (int bi = 0; bi < 4 - d; bi++) {
        int i = d + bi, j = bi;
        float t = 0.f;
#pragma unroll
        for (int mm = 0; mm < 16; mm++) t -= Tf[(16 * i + rr) * 68 + 16 * i + mm] * Mt[bi * 256 + mm * 16 + cc];
        Tf[(16 * i + rr) * 68 + 16 * j + cc] = t;
      }
      __syncthreads();
    }
  }
#pragma unroll
  for (int k = 0; k < 16; k++) {
    int e = tid + 256 * k, i = e >> 6, j = e & 63;
    float v = ((i >> 4) >= (j >> 4)) ? Tf[i * 68 + j] : 0.f;
    Tb[i * 72 + j] = f2bf(v);
  }
  __syncthreads();
  {
    f32x4 aU[8], aW[8];
#pragma unroll
    for (int nt = 0; nt < 8; nt++) { aU[nt] = f32x4{0, 0, 0, 0}; aW[nt] = f32x4{0, 0, 0, 0}; }
#pragma unroll
    for (int ks = 0; ks < 2; ks++) {
      bf16x8 aT = ldsfrag(Tb + (wave * 16 + r) * 72 + ks * 32 + q * 8);
#pragma unroll
      for (int nt = 0; nt < 8; nt++) {
        aU[nt] = mfma16(aT, ldsfrag(VbT + (nt * 16 + r) * 72 + ks * 32 + q * 8), aU[nt]);
        aW[nt] = mfma16(aT, ldsfrag(KbT + (nt * 16 + r) * 72 + ks * 32 + q * 8), aW[nt]);
      }
    }
    bf16_t* Uo = (bf16_t*)(wsb(p) + OFF_U) + (size_t)item * 8192;
    bf16_t* Wo = (bf16_t*)(wsb(p) + OFF_WNEG) + (size_t)item * 8192;
#pragma unroll
    for (int nt = 0; nt < 8; nt++)
#pragma unroll
      for (int e = 0; e < 4; e++) {
        int i = wave * 16 + q * 4 + e, col = nt * 16 + r;
        Uo[i * 128 + col] = f2bf(aU[nt][e]);
        Wo[i * 128 + col] = f2bf(-aW[nt][e]);
      }
  }
  __syncthreads();
}

__device__ __forceinline__ void phase_mlaup(const Params& p, int l, char* smem, int rep = 0) {
  constexpr int MT = NTOK / 128;
  constexpr int N_Q = MT * 6, N_KV = MT * 8;
  const bf16_t* CQN = (const bf16_t*)(wsb(p) + OFF_CQN);
  const bf16_t* CKVN = (const bf16_t*)(wsb(p) + OFF_CKVN);
  bf16_t* QRAW = (bf16_t*)(wsb(p) + OFF_QRAW);
  bf16_t* KRAW = (bf16_t*)(wsb(p) + OFF_KRAW);
  bf16_t* MVTL = (bf16_t*)(wsb(p) + OFF_MVTL);
  bf16_t* MVTC = (bf16_t*)(wsb(p) + OFF_MVTC);
  const bf16_t* WQ = (const bf16_t*)(wsb(p) + OFF_WUQ) + (size_t)l * 768 * 384;
  const bf16_t* WKV = (const bf16_t*)(wsb(p) + OFF_WUKV) + (size_t)l * 1024 * 256;
  const int xcd = bid_opaque() & 7;
  int* ctr = (int*)(wsb(p) + OFF_WQ) + (l * 8 + xcd) + rep * 128;
  constexpr int NG_X = NGITEM / 8;
  constexpr int NQ_X = 17 * 3, NKV_X = 17 * 4;
  int it = wq_next(ctr, smem);
  while (it < NG_X) { gdn_chunk_prep(p, xcd * NG_X + it, smem); it = wq_next(ctr, smem); }
  while (it < NG_X + NQ_X) {
    int i = it - NG_X;
    int mt = xcd + 8 * (i / 3), nt = i % 3, m0 = mt * 128, n0 = nt * 256;
    f32x4 acc[4][8];
    gemm128x256(CQN + (size_t)m0 * 384, 384, WQ + (size_t)n0 * 384, 384, 384, smem, acc);
    ctile256_stage_bf16(smem, acc);
    ctile256_store_rows(smem, QRAW + (size_t)m0 * 768 + n0, 768, 0, 256);
    __syncthreads();
    it = wq_next(ctr, smem);
  }
  while (it < NG_X + NQ_X + NKV_X) {
    int i = it - NG_X - NQ_X;
    int mt = xcd + 8 * (i >> 2), hh = i & 3, m0 = mt * 128, n0 = hh * 256;
    int isc, b, t0; tok_decode(m0, isc, b, t0);
    f32x4 acc[4][8];
    gemm128x256(CKVN + (size_t)m0 * 256, 256, WKV + (size_t)n0 * 256, 256, 256, smem, acc);
    ctile256_stage_bf16(smem, acc);
    ctile256_store_rows(smem, KRAW + (size_t)m0 * 512 + hh * 128, 512, 0, 128);
    ctile256_store_transposed(smem, [&](int n) -> bf16_t* {
      if (n < 128) return nullptr;
      int d = n - 128;
      return isc ? MVTC + ((size_t)((b * 4 + hh) * 128 + d)) * TC + t0 : MVTL + ((size_t)((b * 4 + hh) * 128 + d)) * TL + t0;
    });
    __syncthreads();
    it = wq_next(ctr, smem);
  }
}

__device__ __forceinline__ void phase_prep2(const Params& p, int l) {
  const int wave = tid_opaque() >> 6, lane = tid_opaque() & 63;
  const bf16_t* QRAW = (const bf16_t*)(wsb(p) + OFF_QRAW);
  const bf16_t* KRAW = (const bf16_t*)(wsb(p) + OFF_KRAW);
  const bf16_t* PROJ = (const bf16_t*)(wsb(p) + OFF_PROJ);
  bf16_t* MQ = (bf16_t*)(wsb(p) + OFF_MQ);
  bf16_t* MK = (bf16_t*)(wsb(p) + OFF_MK);
  const float* qn = inp(p, 19) + l * 192;
  const float* kn = inp(p, 20) + l * 192;
  const int f = lane & 15;
  const float inv_freq = exp2f(-(float)f * (13.287712379549449f / 16.f));
  const bool second = (lane & 16) != 0;
  for (int it = bid_opaque(); it < NTOK / 4; it += gridDim.x) {
    int tok = it * 4 + wave;
    int isc, b, t; tok_decode(tok, isc, b, t);
    float pos = (lane < 32) ? (float)(t >> 6) : (float)(t & 63);
    float ang = pos * inv_freq;
    float cs = __cosf(ang), sn = __sinf(ang);
    float krv = bf2f(PROJ[(size_t)tok * DIN + C_MKR + lane]);
    float xq[4][3], xk[4][2];
#pragma unroll
    for (int h = 0; h < 4; h++) {
      const bf16_t* sq = QRAW + (size_t)tok * 768 + h * 192;
      const bf16_t* sk = KRAW + (size_t)tok * 512 + h * 128;
      xq[h][0] = bf2f(sq[lane]); xq[h][1] = bf2f(sq[lane + 64]); xq[h][2] = bf2f(sq[lane + 128]);
      xk[h][0] = bf2f(sk[lane]); xk[h][1] = bf2f(sk[lane + 64]);
    }
    const float qn0 = qn[lane], qn1 = qn[lane + 64], qn2 = qn[lane + 128];
    const float kn0 = kn[lane], kn1 = kn[lane + 64], kn2 = kn[lane + 128];
#pragma unroll
    for (int h = 0; h < 4; h++) {
#pragma unroll
      for (int isk = 0; isk < 2; isk++) {
        float x0 = isk ? xk[h][0] : xq[h][0], x1 = isk ? xk[h][1] : xq[h][1], x2 = isk ? krv : xq[h][2];
        float ss = wave_sum(x0 * x0 + x1 * x1 + x2 * x2);
        float rn = rsqrtf(ss * (1.f / 192.f) + EPS);
        x0 *= rn * (isk ? kn0 : qn0); x1 *= rn * (isk ? kn1 : qn1); x2 *= rn * (isk ? kn2 : qn2);
        if (!isc) {
          float other = __shfl_xor(x2, 16);
          x2 = second ? (x2 * cs + other * sn) : (x2 * cs - other * sn);
        }
        bf16_t* d = (isk ? MK : MQ) + (size_t)tok * 768 + h * 192;
        d[lane] = f2bf(x0); d[lane + 64] = f2bf(x1); d[lane + 128] = f2bf(x2);
      }
    }
  }
}

struct KSeg { const bf16_t* k; const bf16_t* vt; int vt_stride; int n; };

template <int DQ, int MT, bool NA>
__device__ __forceinline__ void attn_item(char* smem, const bf16_t* __restrict__ qptr, int qstride, KSeg s0, KSeg s1, int kstride, float scale,
                          const float* __restrict__ rpb_h, int rr, int row0,
                          const bf16_t* __restrict__ zptr, bf16_t* __restrict__ optr, bool enabled) {
  constexpr int KS = DQ + 8, KSB = KS * 2;
  constexpr int KIMG = 32 * KSB;
  constexpr int NKI = (KIMG + 1023) / 1024;
  constexpr int KREG = NKI * 1024;
  constexpr int VS = 40, VSB = 80, NVI = 10, VREG = 10240;
  constexpr int STAGE = KREG + VREG;
  constexpr int NTOT = NKI + NVI;
  constexpr int NIW = (NTOT + 3) / 4;
  static_assert(3 * STAGE + 1024 + 2048 <= LDS_BYTES - 16, "attention LDS");
  char* dump = smem + 3 * STAGE;
  float* rpbl = (float*)(dump + 1024);
  const int tid = tid_opaque(), wave = tid >> 6, lane = tid & 63, r = lane & 15, q = lane >> 4;
  if (NA) {
    for (int e = tid; e < 15 * 31; e += 256) rpbl[e] = rpb_h[e] * 1.4426950408889634f;
  }
  bf16x8 aq[MT][DQ / 32];
#pragma unroll
  for (int mt = 0; mt < MT; mt++)
#pragma unroll
    for (int ks = 0; ks < DQ / 32; ks++)
      aq[mt][ks] = *(const bf16x8*)(qptr + (size_t)(wave * 16 * MT + mt * 16 + r) * qstride + ks * 32 + q * 8);
  float mrow[MT], lrow[MT];
  f32x4 O[MT][8];
#pragma unroll
  for (int mt = 0; mt < MT; mt++) {
    mrow[mt] = -1e30f; lrow[mt] = 0.f;
#pragma unroll
    for (int nt = 0; nt < 8; nt++) O[mt][nt] = f32x4{0, 0, 0, 0};
  }
  const int n0t = 2 * s0.n, nt2 = 2 * (s0.n + s1.n);
  const float scale2 = scale * 1.4426950408889634f;
  int a_goff[NIW], a_vrow[NIW], a_lds[NIW];
#pragma unroll
  for (int i_ = 0; i_ < NIW; i_++) {
    int wi_ = wave + 4 * i_;
    if (wi_ < NKI) {
      int pos_ = wi_ * 1024 + lane * 16, row_ = pos_ / KSB, off_ = pos_ - row_ * KSB;
      bool ok_ = (row_ < 32) && (off_ < DQ * 2);
      a_goff[i_] = ok_ ? row_ * kstride * 2 + off_ : 0;
      a_vrow[i_] = 0;
      a_lds[i_] = pos_;
    } else if (wi_ < NTOT) {
      int pos_ = (wi_ - NKI) * 1024 + lane * 16, row_ = pos_ / VSB, off_ = pos_ - row_ * VSB;
      bool ok_ = off_ < 64;
      a_goff[i_] = ok_ ? off_ : 0;
      a_vrow[i_] = ok_ ? row_ : 0;
      a_lds[i_] = KREG + pos_;
    } else {
      a_goff[i_] = 0; a_vrow[i_] = 0; a_lds[i_] = 3 * STAGE + lane * 16;
    }
  }
#define ATT_ISSUE(T2, ST)                                                                          \
  {                                                                                                \
    int tc_ = min((T2), nt2 - 1);                                                                  \
    bool f_ = tc_ < n0t;                                                                           \
    int ki_ = f_ ? tc_ : tc_ - n0t;                                                                \
    const char* kp_ = (const char*)((f_ ? s0.k : s1.k) + (size_t)ki_ * 32 * kstride);             \
    const char* vp_ = (const char*)((f_ ? s0.vt : s1.vt) + ki_ * 32);                              \
    const int vtsb_ = (f_ ? s0.vt_stride : s1.vt_stride) * 2;                                      \
    char* sb_ = smem + (ST) * STAGE;                                                               \
    _Pragma("unroll") for (int i_ = 0; i_ < NIW; i_++) {                                           \
      int wi_ = wave + 4 * i_;                                                                     \
      const char* src_; char* dst_;                                                                \
      if (wi_ < NKI) { src_ = kp_ + a_goff[i_]; dst_ = sb_ + a_lds[i_]; }                          \
      else if (wi_ < NTOT) { src_ = vp_ + (a_vrow[i_] * vtsb_ + a_goff[i_]); dst_ = sb_ + a_lds[i_]; } \
      else { src_ = kp_; dst_ = smem + a_lds[i_]; }                                                \
      __builtin_amdgcn_global_load_lds((const unsigned*)src_, (unsigned*)dst_, 16, 0, 0);          \
    }                                                                                              \
  }
  ATT_ISSUE(0, 0)
  ATT_ISSUE(1, 1)
  int st = 0;
  for (int t = 0; t < nt2; t++) {
    asm volatile("s_waitcnt vmcnt(%0)" ::"n"(NIW) : "memory");
    lds_barrier();
    {
      int st2 = st + 2; if (st2 >= 3) st2 -= 3;
      ATT_ISSUE(t + 2, st2)
    }
    const bf16_t* Kst = (const bf16_t*)(smem + st * STAGE);
    const bf16_t* Vst = (const bf16_t*)(smem + st * STAGE + KREG);
    const bool first = t < n0t;
    const int ki = first ? t : t - n0t;
    f32x4 S[MT][2];
#pragma unroll
    for (int mt = 0; mt < MT; mt++)
#pragma unroll
      for (int nt = 0; nt < 2; nt++) S[mt][nt] = f32x4{0, 0, 0, 0};
    __builtin_amdgcn_s_setprio(1);
#pragma unroll
    for (int ks = 0; ks < DQ / 32; ks++) {
      bf16x8 ak[2];
#pragma unroll
      for (int nt = 0; nt < 2; nt++) ak[nt] = ldsfrag(Kst + (nt * 16 + r) * KS + ks * 32 + q * 8);
#pragma unroll
      for (int mt = 0; mt < MT; mt++)
#pragma unroll
        for (int nt = 0; nt < 2; nt++) S[mt][nt] = mfma16(ak[nt], aq[mt][ks], S[mt][nt]);
    }
    __builtin_amdgcn_s_setprio(0);
    bf16x8 bp[MT];
#pragma unroll
    for (int mt = 0; mt < MT; mt++) {
      float mx = -1e30f;
#pragma unroll
      for (int nt = 0; nt < 2; nt++)
#pragma unroll
        for (int e = 0; e < 4; e++) {
          float sv = S[mt][nt][e] * scale2;
          if (NA) {
            if (first) {
              int qcol = wave * 16 + r, kcol = (ki & 1) * 32 + nt * 16 + q * 4 + e;
              int win0 = min(max(qcol - 8, 0), 48);
              bool valid = (kcol >= win0) && (kcol < win0 + 16);
              int dri = row0 + (ki >> 1) - rr + 7, dci = min(max(kcol - qcol + 15, 0), 30);
              sv = valid ? sv + rpbl[dri * 31 + dci] : -1e30f;
            }
          }
          S[mt][nt][e] = sv;
          mx = fmaxf(mx, sv);
        }
      mx = fmaxf(mx, __shfl_xor(mx, 16));
      mx = fmaxf(mx, __shfl_xor(mx, 32));
      float mnew = fmaxf(mrow[mt], mx);
      const bool grew = __any(mnew > mrow[mt]);
      float alpha = __builtin_amdgcn_exp2f(mrow[mt] - mnew);
      mrow[mt] = mnew;
      float rs = 0.f;
#pragma unroll
      for (int nt = 0; nt < 2; nt++)
#pragma unroll
        for (int e = 0; e < 4; e++) {
          float pv = __builtin_amdgcn_exp2f(S[mt][nt][e] - mnew);
          S[mt][nt][e] = pv;
          rs += pv;
        }
      lrow[mt] = lrow[mt] * alpha + rs;
      if (grew) {
#pragma unroll
        for (int nt = 0; nt < 8; nt++)
#pragma unroll
          for (int e = 0; e < 4; e++) O[mt][nt][e] *= alpha;
      }
      u32x4 pk;
      pk[0] = pack2(S[mt][0][0], S[mt][0][1]);
      pk[1] = pack2(S[mt][0][2], S[mt][0][3]);
      pk[2] = pack2(S[mt][1][0], S[mt][1][1]);
      pk[3] = pack2(S[mt][1][2], S[mt][1][3]);
      bp[mt] = __builtin_bit_cast(bf16x8, pk);
    }
    __builtin_amdgcn_s_setprio(1);
#pragma unroll
    for (int nt = 0; nt < 8; nt++) {
      const bf16_t* vrow = Vst + (nt * 16 + r) * VS + q * 4;
      u32x2 lo = *(const u32x2*)vrow;
      u32x2 hi = *(const u32x2*)(vrow + 16);
      u32x4 vv; vv[0] = lo[0]; vv[1] = lo[1]; vv[2] = hi[0]; vv[3] = hi[1];
      bf16x8 av = __builtin_bit_cast(bf16x8, vv);
#pragma unroll
      for (int mt = 0; mt < MT; mt++) O[mt][nt] = mfma16(av, bp[mt], O[mt][nt]);
    }
    __builtin_amdgcn_s_setprio(0);
    st = (st == 2) ? 0 : st + 1;
  }
#undef ATT_ISSUE
  asm volatile("s_waitcnt vmcnt(0)" ::: "memory");
#pragma unroll
  for (int mt = 0; mt < MT; mt++) {
    float l = lrow[mt];
    l += __shfl_xor(l, 16);
    l += __shfl_xor(l, 32);
    float inv = 1.f / l;
    int row = wave * 16 * MT + mt * 16 + r;
    u32x2 zz[8];
#pragma unroll
    for (int nt = 0; nt < 8; nt++) zz[nt] = *(const u32x2*)(zptr + (size_t)row * DIN + nt * 16 + q * 4);
#pragma unroll
    for (int nt = 0; nt < 8; nt++) {
      int d = nt * 16 + q * 4;
      f32x4 o;
      o[0] = O[mt][nt][0] * inv * siluf(lo2f(zz[nt][0]));
      o[1] = O[mt][nt][1] * inv * siluf(hi2f(zz[nt][0]));
      o[2] = O[mt][nt][2] * inv * siluf(lo2f(zz[nt][1]));
      o[3] = O[mt][nt][3] * inv * siluf(hi2f(zz[nt][1]));
      u32x2 pk = pack4(o);
      if (!enabled) pk = u32x2{0u, 0u};
      *(u32x2*)(optr + (size_t)row * DM + d) = pk;
    }
  }
  __syncthreads();
}

__device__ __forceinline__ void gdn_chain(const Params& p, int item, char* smem) {
  bf16_t* Wl = (bf16_t*)smem;
  bf16_t* Qd = Wl + 64 * 136;
  bf16_t* KdT = Qd + 64 * 136;
  bf16_t* QKl = KdT + 128 * 72;
  bf16_t* St = QKl + 64 * 72;
  bf16_t* VNt = St + 32 * 136;
  const int tid = tid_opaque(), wave = tid >> 6, lane = tid & 63, r = lane & 15, q = lane >> 4;
  const int s = item & 3, dir = (item >> 2) & 1, h = (item >> 3) & 3, b = item >> 5;
  const bf16_t* GQ = (const bf16_t*)(wsb(p) + OFF_GQ);
  const bf16_t* GK = (const bf16_t*)(wsb(p) + OFF_GK);
  const float* GAM = (const float*)(wsb(p) + OFF_GAM);
  bf16_t* GO = (bf16_t*)(wsb(p) + OFF_GO) + (size_t)dir * NTOK * 512;
  const int ic0 = ((b * 4 + h) * 2 + dir) * NCHUNK;
  const bf16_t* WNb = (const bf16_t*)(wsb(p) + OFF_WNEG) + (size_t)ic0 * 8192;
  const bf16_t* Ub = (const bf16_t*)(wsb(p) + OFF_U) + (size_t)ic0 * 8192;
  const bf16_t* QKb = (const bf16_t*)(wsb(p) + OFF_QK) + (size_t)ic0 * 4096;
  const float* GAMb = GAM + (size_t)ic0 * 64;
  f32x4 Sacc[2][2];
#pragma unroll
  for (int mt = 0; mt < 2; mt++)
#pragma unroll
    for (int nt = 0; nt < 2; nt++) Sacc[mt][nt] = f32x4{0, 0, 0, 0};
  u32x4 pW[4], pQ[4], pK[4], pQK[2];
  bf16_t pU[8];
  float pgq[4], pgk, pgl;
#define GDN_PREFETCH(cc)                                                                          \
  {                                                                                               \
    const bf16_t* Wn = WNb + (size_t)(cc) * 8192;                                                 \
    const bf16_t* Ug = Ub + (size_t)(cc) * 8192;                                                  \
    const bf16_t* QKg = QKb + (size_t)(cc) * 4096;                                                \
    const float* gam = GAMb + (size_t)(cc) * 64;                                                  \
    _Pragma("unroll") for (int i = 0; i < 4; i++) {                                               \
      int ch = tid + 256 * i, row = ch >> 4, c8 = (ch & 15) * 8;                                  \
      pW[i] = *(const u32x4*)(Wn + row * 128 + c8);                                               \
      int tok = chain_tok(b, dir, (cc), row);                                                     \
      pQ[i] = *(const u32x4*)(GQ + (size_t)tok * 512 + h * 128 + c8);                             \
      pgq[i] = gam[row];                                                                          \
    }                                                                                             \
    {                                                                                             \
      int tokl = chain_tok(b, dir, (cc), lane);                                                   \
      const bf16_t* src = GK + (size_t)tokl * 512 + h * 128 + wave * 32;                          \
      _Pragma("unroll") for (int i = 0; i < 4; i++) pK[i] = *(const u32x4*)(src + i * 8);         \
      pgk = gam[lane]; pgl = gam[63];                                                             \
    }                                                                                             \
    _Pragma("unroll") for (int i = 0; i < 2; i++) {                                               \
      int ch = tid + 256 * i, row = ch >> 3, c8 = (ch & 7) * 8;                                   \
      pQK[i] = *(const u32x4*)(QKg + row * 64 + c8);                                              \
    }                                                                                             \
    _Pragma("unroll") for (int nt = 0; nt < 2; nt++)                                              \
      _Pragma("unroll") for (int e = 0; e < 4; e++)                                               \
        pU[nt * 4 + e] = Ug[(wave * 16 + q * 4 + e) * 128 + s * 32 + nt * 16 + r];                \
  }
  f32x4 aprev[2] = {f32x4{0, 0, 0, 0}, f32x4{0, 0, 0, 0}};
  GDN_PREFETCH(0)
  for (int c = 0; c < NCHUNK; c++) {
#pragma unroll
    for (int i = 0; i < 4; i++) {
      int ch = tid + 256 * i, row = ch >> 4, c8 = (ch & 15) * 8;
      *(u32x4*)(Wl + row * 136 + c8) = pW[i];
      float eg = __expf(pgq[i]);
      u32x4 v = pQ[i], o;
      o.x = pack2(lo2f(v.x) * eg, hi2f(v.x) * eg); o.y = pack2(lo2f(v.y) * eg, hi2f(v.y) * eg);
      o.z = pack2(lo2f(v.z) * eg, hi2f(v.z) * eg); o.w = pack2(lo2f(v.w) * eg, hi2f(v.w) * eg);
      *(u32x4*)(Qd + row * 136 + c8) = o;
    }
    {
      float ek = __expf(pgl - pgk);
#pragma unroll
      for (int i = 0; i < 4; i++) {
        u32x4 v = pK[i];
        int d0 = wave * 32 + i * 8;
#pragma unroll
        for (int e = 0; e < 4; e++) {
          unsigned pk = pack2(lo2f(v[e]) * ek, hi2f(v[e]) * ek);
          KdT[(d0 + 2 * e) * 72 + lane] = (bf16_t)pk;
          KdT[(d0 + 2 * e + 1) * 72 + lane] = (bf16_t)(pk >> 16);
        }
      }
    }
#pragma unroll
    for (int i = 0; i < 2; i++) {
      int ch = tid + 256 * i, row = ch >> 3, c8 = (ch & 7) * 8;
      *(u32x4*)(QKl + row * 72 + c8) = pQK[i];
    }
#pragma unroll
    for (int mt = 0; mt < 2; mt++)
#pragma unroll
      for (int nt = 0; nt < 2; nt++)
        *(u32x2*)(St + (nt * 16 + r) * 136 + (2 * wave + mt) * 16 + q * 4) = pack4(Sacc[mt][nt]);
    f32x4 av[2], ao[2];
#pragma unroll
    for (int nt = 0; nt < 2; nt++) {
#pragma unroll
      for (int e = 0; e < 4; e++) av[nt][e] = bf2f(pU[nt * 4 + e]);
      ao[nt] = f32x4{0, 0, 0, 0};
    }
    const float egl = __expf(pgl);
    lds_barrier();
    if (c > 0) {
#pragma unroll
      for (int e = 0; e < 4; e++) {
        int tok = chain_tok(b, dir, c - 1, wave * 16 + q * 4 + e);
#pragma unroll
        for (int nt = 0; nt < 2; nt++) GO[(size_t)tok * 512 + h * 128 + s * 32 + nt * 16 + r] = f2bf(aprev[nt][e]);
      }
    }
    if (c + 1 < NCHUNK) GDN_PREFETCH(c + 1)
#pragma unroll
    for (int ks = 0; ks < 4; ks++) {
      bf16x8 aW = ldsfrag(Wl + (wave * 16 + r) * 136 + ks * 32 + q * 8);
      bf16x8 aQ = ldsfrag(Qd + (wave * 16 + r) * 136 + ks * 32 + q * 8);
#pragma unroll
      for (int nt = 0; nt < 2; nt++) {
        bf16x8 bS = ldsfrag(St + (nt * 16 + r) * 136 + ks * 32 + q * 8);
        av[nt] = mfma16(aW, bS, av[nt]);
        ao[nt] = mfma16(aQ, bS, ao[nt]);
      }
    }
#pragma unroll
    for (int nt = 0; nt < 2; nt++) *(u32x2*)(VNt + (nt * 16 + r) * 72 + wave * 16 + q * 4) = pack4(av[nt]);
    lds_barrier();
#pragma unroll
    for (int mt = 0; mt < 2; mt++)
#pragma unroll
      for (int nt = 0; nt < 2; nt++)
#pragma unroll
        for (int e = 0; e < 4; e++) Sacc[mt][nt][e] *= egl;
#pragma unroll
    for (int kk = 0; kk < 2; kk++) {
      bf16x8 aQK = ldsfrag(QKl + (wave * 16 + r) * 72 + kk * 32 + q * 8);
      bf16x8 bV[2];
#pragma unroll
      for (int nt = 0; nt < 2; nt++) bV[nt] = ldsfrag(VNt + (nt * 16 + r) * 72 + kk * 32 + q * 8);
#pragma unroll
      for (int nt = 0; nt < 2; nt++) ao[nt] = mfma16(aQK, bV[nt], ao[nt]);
#pragma unroll
      for (int mt = 0; mt < 2; mt++) {
        bf16x8 aK = ldsfrag(KdT + ((2 * wave + mt) * 16 + r) * 72 + kk * 32 + q * 8);
#pragma unroll
        for (int nt = 0; nt < 2; nt++) Sacc[mt][nt] = mfma16(aK, bV[nt], Sacc[mt][nt]);
      }
    }
    aprev[0] = ao[0]; aprev[1] = ao[1];
    lds_barrier();
  }
#pragma unroll
  for (int e = 0; e < 4; e++) {
    int tok = chain_tok(b, dir, NCHUNK - 1, wave * 16 + q * 4 + e);
#pragma unroll
    for (int nt = 0; nt < 2; nt++) GO[(size_t)tok * 512 + h * 128 + s * 32 + nt * 16 + r] = f2bf(aprev[nt][e]);
  }
#undef GDN_PREFETCH
}

__device__ __forceinline__ void ssd_chain(const Params& p, int l, int item, char* smem) {
  bf16_t* Cl = (bf16_t*)smem;
  bf16_t* Bl = Cl + 64 * 136;
  bf16_t* BdT = Bl + 64 * 136;
  bf16_t* XdtT = BdT + 128 * 72;
  bf16_t* Hl = XdtT + 32 * 72;
  bf16_t* Scl = Hl + 32 * 136;
  float* cuml = (float*)(Scl + 64 * 72);
  const int tid = tid_opaque(), wave = tid >> 6, lane = tid & 63, r = lane & 15, q = lane >> 4;
  const int ph = item & 1, dir = (item >> 1) & 1, hh = (item >> 2) & 7, b = item >> 5;
  const int grp = hh >> 2;
  const bf16_t* SX = (const bf16_t*)(wsb(p) + OFF_SX);
  const bf16_t* SB = (const bf16_t*)(wsb(p) + OFF_SB);
  const bf16_t* SC = (const bf16_t*)(wsb(p) + OFF_SC);
  const float* SDT = (const float*)(wsb(p) + OFF_SDT);
  bf16_t* SY = (bf16_t*)(wsb(p) + OFF_SY) + (size_t)dir * NTOK * 512;
  const float Ah = -__expf(inp(p, 23)[l * 16 + dir * 8 + hh]);
  f32x4 Hacc[2][2];
#pragma unroll
  for (int mt = 0; mt < 2; mt++)
#pragma unroll
    for (int nt = 0; nt < 2; nt++) Hacc[mt][nt] = f32x4{0, 0, 0, 0};
  u32x4 pC[4], pB[4], pBt[4], pX;
  float pdt;
#define SSD_PREFETCH(cc)                                                                          \
  {                                                                                               \
    _Pragma("unroll") for (int i = 0; i < 4; i++) {                                               \
      int ch = tid + 256 * i, row = ch >> 4, c8 = (ch & 15) * 8;                                  \
      int tok = chain_tok(b, dir, (cc), row);                                                     \
      pC[i] = *(const u32x4*)(SC + (size_t)tok * 256 + grp * 128 + c8);                           \
      pB[i] = *(const u32x4*)(SB + (size_t)tok * 256 + grp * 128 + c8);                           \
    }                                                                                             \
    int tokl = chain_tok(b, dir, (cc), lane);                                                     \
    const bf16_t* src = SB + (size_t)tokl * 256 + grp * 128 + wave * 32;                          \
    _Pragma("unroll") for (int i = 0; i < 4; i++) pBt[i] = *(const u32x4*)(src + i * 8);          \
    pX = *(const u32x4*)(SX + (size_t)tokl * 512 + hh * 64 + ph * 32 + wave * 8);                 \
    pdt = SDT[(size_t)tokl * 16 + dir * 8 + hh];                                                  \
  }
  f32x4 yprev[2] = {f32x4{0, 0, 0, 0}, f32x4{0, 0, 0, 0}};
  SSD_PREFETCH(0)
  for (int c = 0; c < NCHUNK; c++) {
    const float dtl = pdt;
    const float cum = wave_incl_scan(dtl * Ah, lane);
    const float cum_last = lane_bcast(cum, 63);
    if (wave == 0) cuml[lane] = cum;
#pragma unroll
    for (int i = 0; i < 4; i++) {
      int ch = tid + 256 * i, row = ch >> 4, c8 = (ch & 15) * 8;
      *(u32x4*)(Cl + row * 136 + c8) = pC[i];
      *(u32x4*)(Bl + row * 136 + c8) = pB[i];
    }
    {
      float ek = __expf(cum_last - cum);
#pragma unroll
      for (int i = 0; i < 4; i++) {
        u32x4 v = pBt[i];
        int d0 = wave * 32 + i * 8;
#pragma unroll
        for (int e = 0; e < 4; e++) {
          unsigned pk = pack2(lo2f(v[e]) * ek, hi2f(v[e]) * ek);
          BdT[(d0 + 2 * e) * 72 + lane] = (bf16_t)pk;
          BdT[(d0 + 2 * e + 1) * 72 + lane] = (bf16_t)(pk >> 16);
        }
      }
      u32x4 v = pX;
      int p0 = wave * 8;
#pragma unroll
      for (int e = 0; e < 4; e++) {
        unsigned pk = pack2(lo2f(v[e]) * dtl, hi2f(v[e]) * dtl);
        XdtT[(p0 + 2 * e) * 72 + lane] = (bf16_t)pk;
        XdtT[(p0 + 2 * e + 1) * 72 + lane] = (bf16_t)(pk >> 16);
      }
    }
#pragma unroll
    for (int mt = 0; mt < 2; mt++)
#pragma unroll
      for (int nt = 0; nt < 2; nt++)
        *(u32x2*)(Hl + (nt * 16 + r) * 136 + (2 * wave + mt) * 16 + q * 4) = pack4(Hacc[mt][nt]);
    lds_barrier();
    if (c > 0) {
#pragma unroll
      for (int e = 0; e < 4; e++) {
        int tok = chain_tok(b, dir, c - 1, wave * 16 + q * 4 + e);
#pragma unroll
        for (int nt = 0; nt < 2; nt++) SY[(size_t)tok * 512 + hh * 64 + ph * 32 + nt * 16 + r] = f2bf(yprev[nt][e]);
      }
    }
    if (c + 1 < NCHUNK) SSD_PREFETCH(c + 1)
    f32x4 as[4], ay[2];
#pragma unroll
    for (int nt = 0; nt < 4; nt++) as[nt] = f32x4{0, 0, 0, 0};
#pragma unroll
    for (int nt = 0; nt < 2; nt++) ay[nt] = f32x4{0, 0, 0, 0};
#pragma unroll
    for (int ks = 0; ks < 4; ks++) {
      bf16x8 aC = ldsfrag(Cl + (wave * 16 + r) * 136 + ks * 32 + q * 8);
#pragma unroll
      for (int nt = 0; nt < 4; nt++) as[nt] = mfma16(aC, ldsfrag(Bl + (nt * 16 + r) * 136 + ks * 32 + q * 8), as[nt]);
#pragma unroll
      for (int nt = 0; nt < 2; nt++) ay[nt] = mfma16(aC, ldsfrag(Hl + (nt * 16 + r) * 136 + ks * 32 + q * 8), ay[nt]);
    }
#pragma unroll
    for (int e = 0; e < 4; e++) {
      int i = wave * 16 + q * 4 + e;
      float ci = cuml[i];
      float ei = __expf(ci);
#pragma unroll
      for (int nt = 0; nt < 2; nt++) ay[nt][e] *= ei;
#pragma unroll
      for (int nt = 0; nt < 4; nt++) {
        int j = nt * 16 + r;
        float v = (j <= i) ? as[nt][e] * __expf(ci - cuml[j]) : 0.f;
        Scl[i * 72 + j] = f2bf(v);
      }
    }
    lds_barrier();
    const float ecl = __expf(cum_last);
#pragma unroll
    for (int mt = 0; mt < 2; mt++)
#pragma unroll
      for (int nt = 0; nt < 2; nt++)
#pragma unroll
        for (int e = 0; e < 4; e++) Hacc[mt][nt][e] *= ecl;
#pragma unroll
    for (int kk = 0; kk < 2; kk++) {
      bf16x8 aS = ldsfrag(Scl + (wave * 16 + r) * 72 + kk * 32 + q * 8);
      bf16x8 bX[2];
#pragma unroll
      for (int nt = 0; nt < 2; nt++) bX[nt] = ldsfrag(XdtT + (nt * 16 + r) * 72 + kk * 32 + q * 8);
#pragma unroll
      for (int nt = 0; nt < 2; nt++) ay[nt] = mfma16(aS, bX[nt], ay[nt]);
#pragma unroll
      for (int mt = 0; mt < 2; mt++) {
        bf16x8 aB = ldsfrag(BdT + ((2 * wave + mt) * 16 + r) * 72 + kk * 32 + q * 8);
#pragma unroll
        for (int nt = 0; nt < 2; nt++) Hacc[mt][nt] = mfma16(aB, bX[nt], Hacc[mt][nt]);
      }
    }
    yprev[0] = ay[0]; yprev[1] = ay[1];
    lds_barrier();
  }
#pragma unroll
  for (int e = 0; e < 4; e++) {
    int tok = chain_tok(b, dir, NCHUNK - 1, wave * 16 + q * 4 + e);
#pragma unroll
    for (int nt = 0; nt < 2; nt++) SY[(size_t)tok * 512 + hh * 64 + ph * 32 + nt * 16 + r] = f2bf(yprev[nt][e]);
  }
#undef SSD_PREFETCH
}

__device__ __forceinline__ void phase_mix(const Params& p, int l, char* smem, int rep = 0) {
  constexpr int N_GC = 128, N_SC = 128, N_ML = NB * 4 * 32, N_MC = NB * 4 * 2, N_NL = NB * 64 * 4, N_NC = NB * 4 * 2;
  constexpr int NT = N_GC + N_SC + N_ML + N_MC + N_NL + N_NC;
  const bf16_t* PROJ = (const bf16_t*)(wsb(p) + OFF_PROJ);
  bf16_t* MIX = (bf16_t*)(wsb(p) + OFF_H);
  const bf16_t* MQ = (const bf16_t*)(wsb(p) + OFF_MQ);
  const bf16_t* MK = (const bf16_t*)(wsb(p) + OFF_MK);
  const bf16_t* MVTL = (const bf16_t*)(wsb(p) + OFF_MVTL);
  const bf16_t* MVTC = (const bf16_t*)(wsb(p) + OFF_MVTC);
  const bf16_t* NQ = (const bf16_t*)(wsb(p) + OFF_NQ);
  const bf16_t* NK = (const bf16_t*)(wsb(p) + OFF_NK);
  const bf16_t* NVTL = (const bf16_t*)(wsb(p) + OFF_NVTL);
  const bf16_t* NVTC = (const bf16_t*)(wsb(p) + OFF_NVTC);
  const float mscale = 0.07216878364870322f;
  const float nscale = 0.08838834764831845f;
  (void)NT;
  const int xcd = bid_opaque() & 7;
  int* ctr = (int*)(wsb(p) + OFF_WQ) + 32 + (l * 8 + xcd) + rep * 128;
  const int lbr = bid_opaque() >> 3;
  const int lbx = ((lbr & 1) == 0 && ((int)gridDim.x >> 3) >= 64) ? (lbr >> 1) : (((int)gridDim.x >> 3) >= 64 ? 1000 : lbr);
  if (lbx < 16) gdn_chain(p, xcd * 16 + lbx, smem);
  else if (lbx < 32) ssd_chain(p, l, xcd * 16 + (lbx - 16), smem);
  if (((int)gridDim.x >> 3) < 32) {
    for (int c = lbx + ((int)gridDim.x >> 3); c < 32; c += ((int)gridDim.x >> 3)) {
      if (c < 16) gdn_chain(p, xcd * 16 + c, smem); else ssd_chain(p, l, xcd * 16 + (c - 16), smem);
    }
  }
  int it = 32 + wq_next(ctr, smem);
  while (it < 100) {
    int tok0, h, b; KSeg s0, s1;
    if (it < 96) {
      int i = it - 32, bh = xcd * 2 + (i >> 5), qb = i & 31; b = bh >> 2; h = bh & 3;
      tok0 = b * TL + qb * 128;
      s1 = KSeg{MK + (size_t)(b * TL) * 768 + h * 192, MVTL + (size_t)((b * 4 + h) * 128) * TL, TL, 64};
    } else {
      int i = it - 96, bh = xcd * 2 + (i >> 1), qb = i & 1; b = bh >> 2; h = bh & 3;
      tok0 = NTOK_L + b * TC + qb * 128;
      s1 = KSeg{MK, MVTL, TL, 0};
    }
    s0 = KSeg{MK + (size_t)(NTOK_L + b * TC) * 768 + h * 192, MVTC + (size_t)((b * 4 + h) * 128) * TC, TC, 4};
    attn_item<192, 2, false>(smem, MQ + (size_t)tok0 * 768 + h * 192, 768, s0, s1, 768, mscale, nullptr, 0, 0,
                             PROJ + (size_t)tok0 * DIN + C_MZ + h * 128, MIX + (size_t)tok0 * DM + 1024 + h * 128, EN_MLA);
    it = 32 + wq_next(ctr, smem);
  }
  while (it < 228) {
    int i = it - 100, bh = xcd * 2 + (i >> 6), rr = i & 63, b = bh >> 2, h = bh & 3;
    int tok0 = b * TL + rr * 64;
    int row0 = min(max(rr - 4, 0), 56);
    KSeg s0{NK + (size_t)(b * TL + row0 * 64) * 512 + h * 128, NVTL + (size_t)((b * 4 + h) * 128) * TL + row0 * 64, TL, 8};
    KSeg s1{NK + (size_t)(NTOK_L + b * TC) * 512 + h * 128, NVTC + (size_t)((b * 4 + h) * 128) * TC, TC, 4};
    attn_item<128, 1, true>(smem, NQ + (size_t)tok0 * 512 + h * 128, 512, s0, s1, 512, nscale,
                            inp(p, 14) + (size_t)(l * 4 + h) * 15 * 31, rr, row0,
                            PROJ + (size_t)tok0 * DIN + C_NZ + h * 128, MIX + (size_t)tok0 * DM + 512 + h * 128, EN_NA);
    it = 32 + wq_next(ctr, smem);
  }
  while (it < 232) {
    int i = it - 228, bh = xcd * 2 + (i >> 1), qb = i & 1, b = bh >> 2, h = bh & 3;
    int tok0 = NTOK_L + b * TC + qb * 128;
    KSeg s0{NK + (size_t)(NTOK_L + b * TC) * 512 + h * 128, NVTC + (size_t)((b * 4 + h) * 128) * TC, TC, 4};
    KSeg s1{NK, NVTC, TC, 0};
    attn_item<128, 2, false>(smem, NQ + (size_t)tok0 * 512 + h * 128, 512, s0, s1, 512, nscale, nullptr, 0, 0,
                             PROJ + (size_t)tok0 * DIN + C_NZ + h * 128, MIX + (size_t)tok0 * DM + 512 + h * 128, EN_NA);
    it = 32 + wq_next(ctr, smem);
  }
}

__device__ __forceinline__ void phase_post(const Params& p, int l) {
  const int wave = tid_opaque() >> 6, lane = tid_opaque() & 63;
  const bf16_t* PROJ = (const bf16_t*)(wsb(p) + OFF_PROJ);
  bf16_t* MIX = (bf16_t*)(wsb(p) + OFF_H);
  const bf16_t* GO = (const bf16_t*)(wsb(p) + OFF_GO);
  const bf16_t* SY = (const bf16_t*)(wsb(p) + OFF_SY);
  const bf16_t* SX = (const bf16_t*)(wsb(p) + OFF_SX);
  const int nit = NTOK / 4, gstep = gridDim.x;
  const float2 gw = *(const float2*)(inp(p, 11) + l * 128 + lane * 2);
  float2 sw[4]; float sd[4];
#pragma unroll
  for (int i = 0; i < 4; i++) {
    sw[i] = *(const float2*)(inp(p, 26) + l * 512 + lane * 2 + 128 * i);
    sd[i] = inp(p, 25)[l * 8 + (lane >> 5) + 2 * i];
  }
  unsigned cu[28], nu[28];
#define POST_LOAD(TOK, U)                                                                         \
  {                                                                                               \
    const bf16_t* P0 = PROJ + (size_t)(TOK) * DIN;                                                \
    _Pragma("unroll") for (int h = 0; h < 4; h++) {                                               \
      int c = h * 128 + lane * 2;                                                                 \
      U[h] = *(const unsigned*)(GO + (size_t)(TOK) * 512 + c);                                    \
      U[4 + h] = *(const unsigned*)(GO + (size_t)NTOK * 512 + (size_t)(TOK) * 512 + c);           \
      U[8 + h] = *(const unsigned*)(P0 + C_GZ + c);                                               \
    }                                                                                             \
    _Pragma("unroll") for (int i = 0; i < 4; i++) {                                               \
      int c = lane * 2 + 128 * i;                                                                 \
      U[12 + i] = *(const unsigned*)(SY + (size_t)(TOK) * 512 + c);                               \
      U[16 + i] = *(const unsigned*)(SY + (size_t)NTOK * 512 + (size_t)(TOK) * 512 + c);          \
      U[20 + i] = *(const unsigned*)(SX + (size_t)(TOK) * 512 + c);                               \
      U[24 + i] = *(const unsigned*)(P0 + C_SZ + c);                                              \
    }                                                                                             \
  }
  int it = bid_opaque();
  if (it < nit) POST_LOAD(it * 4 + wave, cu)
  for (; it < nit; it += gstep) {
    const int tok = it * 4 + wave;
    const bool more = it + gstep < nit;
    if (more) POST_LOAD((it + gstep) * 4 + wave, nu)
#pragma unroll
    for (int h = 0; h < 4; h++) {
      int c = h * 128 + lane * 2;
      float oa = lo2f(cu[h]) + lo2f(cu[4 + h]), ob = hi2f(cu[h]) + hi2f(cu[4 + h]);
      float ss = wave_sum(oa * oa + ob * ob);
      float rn = rsqrtf(ss * (1.f / 128.f) + EPS);
      float ra = oa * rn * gw.x * siluf(lo2f(cu[8 + h]));
      float rb = ob * rn * gw.y * siluf(hi2f(cu[8 + h]));
      *(unsigned*)(MIX + (size_t)tok * DM + c) = EN_GDN ? pack2(ra, rb) : 0u;
    }
    {
      float ya[4], yb[4], ss = 0.f;
#pragma unroll
      for (int i = 0; i < 4; i++) {
        ya[i] = (lo2f(cu[12 + i]) + lo2f(cu[16 + i]) + sd[i] * lo2f(cu[20 + i])) * siluf(lo2f(cu[24 + i]));
        yb[i] = (hi2f(cu[12 + i]) + hi2f(cu[16 + i]) + sd[i] * hi2f(cu[20 + i])) * siluf(hi2f(cu[24 + i]));
        ss += ya[i] * ya[i] + yb[i] * yb[i];
      }
      ss = wave_sum(ss);
      float rn = rsqrtf(ss * (1.f / 512.f) + EPS);
#pragma unroll
      for (int i = 0; i < 4; i++) {
        int c = lane * 2 + 128 * i;
        *(unsigned*)(MIX + (size_t)tok * DM + 1536 + c) = EN_SSD ? pack2(ya[i] * rn * sw[i].x, yb[i] * rn * sw[i].y) : 0u;
      }
    }
    if (more) {
#pragma unroll
      for (int i = 0; i < 28; i++) cu[i] = nu[i];
    }
  }
#undef POST_LOAD
}

__device__ __forceinline__ void phase_outproj(const Params& p, int l, char* smem) {
  const bf16_t* MIX = (const bf16_t*)(wsb(p) + OFF_H);
  const bf16_t* W = (const bf16_t*)(wsb(p) + OFF_WOUT) + (size_t)l * DM * DM;
  const int MTn = (l == NL - 1) ? NTOK_L / 128 : NTOK / 128;
  const int xcd = bid_opaque() & 7, lb = bid_opaque() >> 3, nlb = (int)gridDim.x >> 3;
  const int mper = MTn >> 3;
  const int ntot = mper * 8, nbig = (ntot / nlb) * nlb;
  for (int j = lb; j < nbig; j += nlb) {
    int mi = j >> 3, nt = j & 7;
    int mt = xcd + 8 * mi;
    int m0 = mt * 128, n0 = nt * 256;
    int isc, b, t0; tok_decode(m0, isc, b, t0);
    const float* gate = (const float*)(wsb(p) + OFF_MOD) + (size_t)(l * 5 + (isc ? 4 : b)) * 6144 + 4096;
    f32x4 acc[4][8];
    gemm128x256(MIX + (size_t)m0 * DM, DM, W + (size_t)n0 * DM, DM, DM, smem, acc);
    {
      float* Cf = (float*)smem;
      const int tid = tid_opaque(), wave = tid >> 6, lane = tid & 63, r = lane & 15, q = lane >> 4;
      const int wr = wave >> 1, wc = wave & 1;
      const int c4 = (tid & 31) * 4;
#pragma unroll
      for (int hf = 0; hf < 2; hf++) {
        if (wc == hf) {
#pragma unroll
          for (int i = 0; i < 4; i++)
#pragma unroll
            for (int j2 = 0; j2 < 8; j2++)
              *(f32x4*)(Cf + (wr * 64 + i * 16 + r) * 132 + j2 * 16 + q * 4) = acc[i][j2];
        }
        lds_barrier();
        const int gc = n0 + hf * 128 + c4;
        const f32x4 g = *(const f32x4*)(gate + gc);
#pragma unroll
        for (int c0 = 0; c0 < 16; c0 += 8) {
          f32x4 xv[8];
#pragma unroll
          for (int c = 0; c < 8; c++) {
            int row = (tid >> 5) + 8 * (c0 + c);
            xv[c] = *(const f32x4*)(xrow_src(p, l, m0 + row) + gc);
          }
#pragma unroll
          for (int c = 0; c < 8; c++) {
            int row = (tid >> 5) + 8 * (c0 + c);
            f32x4 y = *(const f32x4*)(Cf + row * 132 + c4);
            *(f32x4*)(xrow_dst(p, m0 + row) + gc) = xv[c] + g * y;
          }
        }
        __syncthreads();
      }
    }
  }
  for (int sidx = lb; sidx < (ntot - nbig) * 2; sidx += nlb) {
    int j = nbig + (sidx >> 1), hf2 = sidx & 1;
    int mi = j >> 3, nt = j & 7;
    int mt = xcd + 8 * mi;
    int m0 = mt * 128, n0 = nt * 256 + hf2 * 128;
    int isc, b, t0; tok_decode(m0, isc, b, t0);
    const float* gate = (const float*)(wsb(p) + OFF_MOD) + (size_t)(l * 5 + (isc ? 4 : b)) * 6144 + 4096;
    f32x4 acc[4][4];
    gemm128(MIX + (size_t)m0 * DM, DM, W + (size_t)n0 * DM, DM, DM, smem, acc);
    {
      float* Cf = (float*)smem;
      const int tid = tid_opaque(), wave = tid >> 6, lane = tid & 63, r = lane & 15, q = lane >> 4;
      const int wr = wave >> 1, wc = wave & 1;
#pragma unroll
      for (int i = 0; i < 4; i++)
#pragma unroll
        for (int j2 = 0; j2 < 4; j2++)
          *(f32x4*)(Cf + (wr * 64 + i * 16 + r) * 132 + wc * 64 + j2 * 16 + q * 4) = acc[i][j2];
      lds_barrier();
      const int c4 = (tid & 31) * 4;
      const f32x4 g = *(const f32x4*)(gate + n0 + c4);
#pragma unroll
      for (int c0 = 0; c0 < 16; c0 += 8) {
        f32x4 xv[8];
#pragma unroll
        for (int c = 0; c < 8; c++) {
          int row = (tid >> 5) + 8 * (c0 + c);
          xv[c] = *(const f32x4*)(xrow_src(p, l, m0 + row) + n0 + c4);
        }
#pragma unroll
        for (int c = 0; c < 8; c++) {
          int row = (tid >> 5) + 8 * (c0 + c);
          f32x4 y = *(const f32x4*)(Cf + row * 132 + c4);
          *(f32x4*)(xrow_dst(p, m0 + row) + n0 + c4) = xv[c] + g * y;
        }
      }
    }
    __syncthreads();
  }
}

#define XB_TMO      128
#define XB_XCNT(j)  (256  + 64 * (j))
#define XB_XSUB(j)  (1280 + 64 * (j))
#define XB_XGEN(j)  (2304 + 64 * (j))
#define XB_TOP      3328
#define XB_TOPGEN   3392
#define XCD_BAR_WORDS 3456
#define XB_SPIN_CAP (1u << 20)
#define LAS __attribute__((address_space(3)))
__device__ __forceinline__ unsigned xb_ld(unsigned* p)              { return __hip_atomic_load(p, __ATOMIC_RELAXED, __HIP_MEMORY_SCOPE_AGENT); }
__device__ __forceinline__ unsigned xb_add(unsigned* p, unsigned v) { return __hip_atomic_fetch_add(p, v, __ATOMIC_RELAXED, __HIP_MEMORY_SCOPE_AGENT); }
__device__ __forceinline__ unsigned xb_xcc_id() { return (unsigned)__builtin_amdgcn_s_getreg((3 << 11) | 20) & 0xFu; }
#define XB_SPIN(cond, bar) do { unsigned _sp = 0; while (cond) { __builtin_amdgcn_s_sleep(1); \
    if ((++_sp & 255u) == 0u) { if (xb_ld(&(bar)[XB_TMO])) break; if (_sp > XB_SPIN_CAP) { atomicAdd(&(bar)[XB_TMO], 1u); break; } } } } while (0)
struct XcdBarrier { unsigned* bar; unsigned x; volatile LAS unsigned* st; };
__device__ __forceinline__ XcdBarrier xcd_barrier_post(unsigned* bar, volatile LAS unsigned* st) {
  XcdBarrier b; b.bar = bar; b.x = xb_xcc_id(); b.st = st;
  if (threadIdx.x == 0) (void)xb_add(&bar[XB_XCNT(b.x)], 1u);
  return b;
}
__device__ __forceinline__ void xcd_barrier_complete(unsigned* bar, unsigned x, unsigned& nloc, unsigned& nx) {
  const unsigned G = gridDim.x * gridDim.y * gridDim.z;
  unsigned sum, cnt, mine, sp = 0u;
  for (;;) {
    sum = 0u; cnt = 0u; mine = 0u;
#pragma unroll
    for (unsigned j = 0; j < 16; ++j) { const unsigned c = xb_ld(&bar[XB_XCNT(j)]); sum += c; cnt += (c > 0u) ? 1u : 0u; mine = (j == x) ? c : mine; }
    if (sum == G) break;
    __builtin_amdgcn_s_sleep(1);
    if ((++sp & 255u) == 0u) { if (xb_ld(&bar[XB_TMO])) break; if (sp > XB_SPIN_CAP) { atomicAdd(&bar[XB_TMO], 1u); break; } }
  }
  nloc = mine > 0u ? mine : 1u; nx = cnt > 0u ? cnt : 1u;
}
__device__ __forceinline__ void xcd_barrier(const XcdBarrier& b) {
  asm volatile("s_waitcnt vmcnt(0)" ::: "memory");
  __syncthreads();
  if (threadIdx.x == 0) {
    unsigned* bar = b.bar;
    __builtin_amdgcn_s_waitcnt(0);
    unsigned nloc = b.st[0], nx = b.st[1];
    if (nloc == 0u) { xcd_barrier_complete(bar, b.x, nloc, nx); b.st[0] = nloc; b.st[1] = nx; }
    const unsigned old = xb_add(&bar[XB_XSUB(b.x)], 1u);
    const unsigned gen = old / nloc;
    if (old + 1u == (gen + 1u) * nloc) {
      __builtin_amdgcn_fence(__ATOMIC_RELEASE, "agent");
      asm volatile("s_waitcnt vmcnt(0)" ::: "memory");
      const unsigned og = xb_add(&bar[XB_TOP], 1u);
      const unsigned tg = og / nx;
      if (og + 1u == (tg + 1u) * nx) xb_add(&bar[XB_TOPGEN], 1u);
      else XB_SPIN(xb_ld(&bar[XB_TOPGEN]) == tg, bar);
      __builtin_amdgcn_fence(__ATOMIC_ACQUIRE, "agent");
      xb_add(&bar[XB_XGEN(b.x)], 1u);
      asm volatile("s_waitcnt vmcnt(0)" ::: "memory");
    } else {
      XB_SPIN(xb_ld(&bar[XB_XGEN(b.x)]) == gen, bar);
      __builtin_amdgcn_fence(__ATOMIC_ACQUIRE, "agent");
      asm volatile("s_waitcnt vmcnt(0)" ::: "memory");
    }
  }
  __syncthreads();
}

__global__ void __launch_bounds__(256, 2) hybrid_megakernel(Params p) {
  extern __shared__ __attribute__((aligned(16))) char smem[];
  cg::grid_group grid = cg::this_grid();
  if (threadIdx.x < 28) ((const float**)(p.ws + OFF_TBL))[threadIdx.x] = p.in[threadIdx.x];
  if (blockIdx.x == 0) {
    ((int*)(p.ws + OFF_WQ))[threadIdx.x] = 0;
    for (int i = threadIdx.x; i < XCD_BAR_WORDS; i += 256) ((unsigned*)(p.ws + OFF_BAR))[i] = 0u;
  }
  volatile LAS unsigned* xst = (volatile LAS unsigned*)(smem + LDS_BYTES - 32);
  if (threadIdx.x == 0) { xst[0] = 0u; xst[1] = 0u; }
  __syncthreads();
  __threadfence();
  grid.sync();
  (void)xcd_barrier_post((unsigned*)(p.ws + OFF_BAR), xst);
#define GSYNC() { XcdBarrier xb_; { char* w_ = p.ws; asm volatile("" : "+s"(w_)); xb_.bar = (unsigned*)(w_ + OFF_BAR); } xb_.x = xb_xcc_id(); xb_.st = (volatile LAS unsigned*)(smem + LDS_BYTES - 32); xcd_barrier(xb_); }
#define LQ Params q = p; { char* w_ = q.ws; asm volatile("" : "+s"(w_)); q.ws = w_; }
  { LQ phase0(q, smem); }
  GSYNC();
  { LQ phase_modred(q); }
  GSYNC();
#pragma unroll 1
  for (int l = 0; l < NL; l++) {
    for (int rep = 0; rep < REP_SMALL; rep++) { { LQ phase_norm(q, l); } GSYNC(); }
    for (int rep = 0; rep < REP_INPROJ; rep++) { { LQ phase_inproj(q, l, smem); } GSYNC(); }
    for (int rep = 0; rep < REP_SMALL; rep++) { { LQ phase_prep(q, l); } GSYNC(); }
    for (int rep = 0; rep < REP_MLAUP; rep++) { { LQ phase_mlaup(q, l, smem, rep); } GSYNC(); }
    for (int rep = 0; rep < REP_SMALL; rep++) { { LQ phase_prep2(q, l); } GSYNC(); }
    for (int rep = 0; rep < REP_MIX; rep++) { { LQ phase_mix(q, l, smem, rep); } GSYNC(); }
    for (int rep = 0; rep < REP_SMALL; rep++) { { LQ phase_post(q, l); } GSYNC(); }
    { LQ phase_outproj(q, l, smem); }
    if (l + 1 < NL) GSYNC();
  }
}

extern "C" void kernel_launch(void* const* d_in, const int* in_sizes, int n_in, void* d_out, int out_size, void* d_ws,
                              size_t ws_size, hipStream_t stream) {
  static int grid_blocks = 0;
  if (grid_blocks == 0) {
    if (n_in != 28 || ws_size < WS_END) {
      fprintf(stderr, "kernel_launch: need 28 inputs and %zu bytes ws; got %d, %zu\n", (size_t)WS_END, n_in, ws_size);
      grid_blocks = -1;
      return;
    }
    int dev = 0, cus = 0, per_cu = 0;
    hipGetDevice(&dev);
    hipDeviceGetAttribute(&cus, hipDeviceAttributeMultiprocessorCount, dev);
    hipFuncSetAttribute((const void*)hybrid_megakernel, hipFuncAttributeMaxDynamicSharedMemorySize, LDS_BYTES);
    hipOccupancyMaxActiveBlocksPerMultiprocessor(&per_cu, (const void*)hybrid_megakernel, 256, LDS_BYTES);
    if (per_cu < 1) per_cu = 1;
    if (per_cu > 2) per_cu = 2;
    grid_blocks = cus * per_cu;
    fprintf(stderr, "kernel_launch: cus=%d per_cu=%d grid=%d ws_need=%zu ws=%zu\n", cus, per_cu, grid_blocks, (size_t)WS_END, ws_size);
  }
  if (grid_blocks < 0) return;
  Params p{};
  for (int i = 0; i < 28; i++) p.in[i] = (const float*)d_in[i];
  p.out = (float*)d_out;
  p.ws = (char*)d_ws;
  void* args[] = {&p};
  hipError_t e = hipLaunchCooperativeKernel((const void*)hybrid_megakernel, dim3(grid_blocks), dim3(256), args, LDS_BYTES, stream);
  if (e != hipSuccess) fprintf(stderr, "cooperative launch failed: %s (grid %d)\n", hipGetErrorString(e), grid_blocks);
}

#ifdef PHASE_TEST
__global__ void __launch_bounds__(256, 2) t_phase0(Params p) { extern __shared__ __attribute__((aligned(16))) char smem[]; phase0(p, smem); }
__global__ void __launch_bounds__(256, 2) t_norm(Params p) { phase_norm(p, 1); }
__global__ void __launch_bounds__(256, 2) t_inproj(Params p) { extern __shared__ __attribute__((aligned(16))) char smem[]; phase_inproj(p, 1, smem); }
__global__ void __launch_bounds__(256, 2) t_prep(Params p) { phase_prep(p, 1); }
__global__ void __launch_bounds__(256, 2) t_gdnprep(Params p) { extern __shared__ __attribute__((aligned(16))) char smem[]; gdn_chunk_prep(p, bid_opaque(), smem); }
__global__ void __launch_bounds__(256, 2) t_mlaup(Params p) { extern __shared__ __attribute__((aligned(16))) char smem[]; phase_mlaup(p, 1, smem); }
__global__ void __launch_bounds__(256, 2) t_prep2(Params p) { phase_prep2(p, 1); }
__global__ void __launch_bounds__(256, 2) t_gdnchain(Params p) { extern __shared__ __attribute__((aligned(16))) char smem[]; gdn_chain(p, bid_opaque(), smem); }
__global__ void __launch_bounds__(256, 2) t_ssdchain(Params p) { extern __shared__ __attribute__((aligned(16))) char smem[]; ssd_chain(p, 1, bid_opaque(), smem); }
__global__ void __launch_bounds__(256, 2) t_mix(Params p) { extern __shared__ __attribute__((aligned(16))) char smem[]; phase_mix(p, 1, smem); }
__global__ void __launch_bounds__(256, 2) t_post(Params p) { phase_post(p, 1); }
__global__ void __launch_bounds__(256, 2) t_outproj(Params p) { extern __shared__ __attribute__((aligned(16))) char smem[]; phase_outproj(p, 1, smem); }
#endif
#ifdef PHASE_TEST
__global__ void __launch_bounds__(256, 2) t_attn192(Params p) { extern __shared__ __attribute__((aligned(16))) char smem[];
  KSeg s0{(const bf16_t*)wsb(p), (const bf16_t*)wsb(p), 256, 4}; KSeg s1{(const bf16_t*)wsb(p), (const bf16_t*)wsb(p), 4096, 64};
  attn_item<192, 2, false>(smem, (const bf16_t*)wsb(p), 768, s0, s1, 768, 0.1f, nullptr, 0, 0, (const bf16_t*)wsb(p), (bf16_t*)wsb(p), true); }
__global__ void __launch_bounds__(256, 2) t_attn128na(Params p) { extern __shared__ __attribute__((aligned(16))) char smem[];
  KSeg s0{(const bf16_t*)wsb(p), (const bf16_t*)wsb(p), 256, 4}; KSeg s1{(const bf16_t*)wsb(p), (const bf16_t*)wsb(p), 4096, 64};
  attn_item<128, 1, true>(smem, (const bf16_t*)wsb(p), 768, s0, s1, 768, 0.1f, inp(p, 14), bid_opaque(), 0, (const bf16_t*)wsb(p), (bf16_t*)wsb(p), true); }
__global__ void __launch_bounds__(256, 2) t_attn128(Params p) { extern __shared__ __attribute__((aligned(16))) char smem[];
  KSeg s0{(const bf16_t*)wsb(p), (const bf16_t*)wsb(p), 256, 4}; KSeg s1{(const bf16_t*)wsb(p), (const bf16_t*)wsb(p), 4096, 64};
  attn_item<128, 2, false>(smem, (const bf16_t*)wsb(p), 768, s0, s1, 768, 0.1f, nullptr, 0, 0, (const bf16_t*)wsb(p), (bf16_t*)wsb(p), true); }
#endif
```

```cpp
#include <hip/hip_runtime.h>
#include <hip/hip_cooperative_groups.h>
#include <cstdio>
namespace cg = cooperative_groups;

typedef unsigned short bf16_t;
using bf16x8 = __attribute__((ext_vector_type(8))) short;
using f32x4 = __attribute__((ext_vector_type(4))) float;
using u32x4 = __attribute__((ext_vector_type(4))) unsigned;
using u32x2 = __attribute__((ext_vector_type(2))) unsigned;

#ifndef EN_GDN
#define EN_GDN 1
#endif
#ifndef EN_NA
#define EN_NA 1
#endif
#ifndef EN_MLA
#define EN_MLA 1
#endif
#ifndef EN_SSD
#define EN_SSD 1
#endif

constexpr int DM = 2048, NB = 4, TL = 4096, TC = 256, NL = 4;
constexpr int NTOK_L = NB * TL, NTOK_C = NB * TC, NTOK = NTOK_L + NTOK_C;
constexpr int DIN = 6880, DINP = 6912;
constexpr int C_GQKV = 0, C_GZ = 1536, C_GBETA = 2048, C_NQKV = 2064, C_NZ = 3600, C_MQ = 4112,
              C_MKV = 4496, C_MKR = 4752, C_MZ = 4816, C_SZ = 5328, C_SXBC = 5840, C_SDT = 6864;
constexpr int NCHUNK = 68;
constexpr int NGITEM = NB * 4 * 2 * NCHUNK;
constexpr float EPS = 1e-6f;

constexpr size_t al(size_t x) { return (x + 255) & ~(size_t)255; }
constexpr size_t OFF_WIN = 0;
constexpr size_t OFF_WOUT = OFF_WIN + al((size_t)NL * DINP * DM * 2);
constexpr size_t OFF_WUQ = OFF_WOUT + al((size_t)NL * DM * DM * 2);
constexpr size_t OFF_WUKV = OFF_WUQ + al((size_t)NL * 768 * 384 * 2);
constexpr size_t OFF_PM = OFF_WUKV + al((size_t)NL * 1024 * 256 * 2);
constexpr size_t OFF_MOD = OFF_PM + al((size_t)NL * 16 * 5 * 6144 * 4);
constexpr size_t OFF_H = OFF_MOD + al((size_t)NL * 5 * 6144 * 4);
constexpr size_t SZ_H = (size_t)NTOK * DM * 2;
constexpr size_t OFF_CQN = OFF_H;
constexpr size_t OFF_CKVN = OFF_CQN + al((size_t)NTOK * 384 * 2);
constexpr size_t OFF_QRAW = OFF_CKVN + al((size_t)NTOK * 256 * 2);
constexpr size_t OFF_KRAW = OFF_QRAW + al((size_t)NTOK * 768 * 2);
static_assert(OFF_KRAW + (size_t)NTOK * 512 * 2 <= OFF_H + SZ_H, "alias overflow");
constexpr size_t OFF_PROJ = OFF_H + al(SZ_H);
constexpr size_t OFF_PSM = OFF_PROJ + al((size_t)NTOK * DIN * 2);
constexpr size_t OFF_GQ = OFF_PSM + al((size_t)NTOK * 32 * 4);
constexpr size_t OFF_GK = OFF_GQ + al((size_t)NTOK * 512 * 2);
constexpr size_t OFF_GV = OFF_GK + al((size_t)NTOK * 512 * 2);
constexpr size_t OFF_GG = OFF_GV + al((size_t)NTOK * 512 * 2);
constexpr size_t OFF_GBETA = OFF_GG + al((size_t)2 * NTOK * 4 * 4);
constexpr size_t OFF_WNEG = OFF_GBETA + al((size_t)2 * NTOK * 4 * 4);
constexpr size_t OFF_U = OFF_WNEG + al((size_t)NGITEM * 64 * 128 * 2);
constexpr size_t OFF_QK = OFF_U + al((size_t)NGITEM * 64 * 128 * 2);
constexpr size_t OFF_GAM = OFF_QK + al((size_t)NGITEM * 64 * 64 * 2);
constexpr size_t OFF_GO = OFF_GAM + al((size_t)NGITEM * 64 * 4);
constexpr size_t OFF_NQ = OFF_GO + al((size_t)2 * NTOK * 512 * 2);
constexpr size_t OFF_NK = OFF_NQ + al((size_t)NTOK * 512 * 2);
constexpr size_t OFF_NVTL = OFF_NK + al((size_t)NTOK * 512 * 2);
constexpr size_t OFF_NVTC = OFF_NVTL + al((size_t)NB * 4 * 128 * TL * 2);
constexpr size_t OFF_MVTL = OFF_NVTC + al((size_t)NB * 4 * 128 * TC * 2);
constexpr size_t OFF_MVTC = OFF_MVTL + al((size_t)NB * 4 * 128 * TL * 2);
constexpr size_t OFF_MQ = OFF_MVTC + al((size_t)NB * 4 * 128 * TC * 2);
constexpr size_t OFF_MK = OFF_MQ + al((size_t)NTOK * 768 * 2);
constexpr size_t OFF_SX = OFF_MK + al((size_t)NTOK * 768 * 2);
constexpr size_t OFF_SB = OFF_SX + al((size_t)NTOK * 512 * 2);
constexpr size_t OFF_SC = OFF_SB + al((size_t)NTOK * 256 * 2);
constexpr size_t OFF_SDT = OFF_SC + al((size_t)NTOK * 256 * 2);
constexpr size_t OFF_SY = OFF_SDT + al((size_t)NTOK * 16 * 4);
constexpr size_t OFF_XC = OFF_SY + al((size_t)2 * NTOK * 512 * 2);
constexpr size_t OFF_TBL = OFF_XC + al((size_t)NTOK_C * DM * 4);
constexpr size_t OFF_WQ = OFF_TBL + 256;
constexpr size_t OFF_BAR = OFF_WQ + 1024;
constexpr size_t WS_END = OFF_BAR + 3456 * 4 + 256;

constexpr int LDS_BYTES = 79 * 1024;
constexpr int REP_INPROJ = 1, REP_MIX = 1, REP_SMALL = 1, REP_MLAUP = 1;

struct Params {
  const float* in[28];
  float* out;
  char* ws;
};

__device__ __forceinline__ float bf2f(bf16_t h) { return __uint_as_float(((unsigned)h) << 16); }
typedef __bf16 hwbf16x2 __attribute__((ext_vector_type(2)));
typedef float hwf32x2 __attribute__((ext_vector_type(2)));
__device__ __forceinline__ unsigned pack2(float a, float b) { hwf32x2 f = {a, b}; return __builtin_bit_cast(unsigned, __builtin_convertvector(f, hwbf16x2)); }
__device__ __forceinline__ bf16_t f2bf(float f) { return (bf16_t)(pack2(f, 0.f) & 0xffffu); }
__device__ __forceinline__ u32x2 pack4(f32x4 v) { return u32x2{pack2(v[0], v[1]), pack2(v[2], v[3])}; }
__device__ __forceinline__ float lo2f(unsigned u) { return __uint_as_float(u << 16); }
__device__ __forceinline__ float hi2f(unsigned u) { return __uint_as_float(u & 0xffff0000u); }
__device__ __forceinline__ float siluf(float x) { return x / (1.f + __expf(-x)); }
__device__ __forceinline__ float softplusf(float x) { return fmaxf(x, 0.f) + __logf(1.f + __expf(-fabsf(x))); }
template <int CTRL>
__device__ __forceinline__ float dpp_mov(float x) {
  return __builtin_bit_cast(float, __builtin_amdgcn_update_dpp(0, __builtin_bit_cast(int, x), CTRL, 0xf, 0xf, true));
}
__device__ __forceinline__ float lane_bcast(float v, int l) {
  return __builtin_bit_cast(float, __builtin_amdgcn_readlane(__builtin_bit_cast(int, v), l));
}
__device__ __forceinline__ float wave_sum(float v) {
  v += dpp_mov<0xB1>(v);
  v += dpp_mov<0x4E>(v);
  v += dpp_mov<0x141>(v);
  v += dpp_mov<0x140>(v);
  return (lane_bcast(v, 0) + lane_bcast(v, 16)) + (lane_bcast(v, 32) + lane_bcast(v, 48));
}
__device__ __forceinline__ float wave_incl_scan(float v, int lane) {
  v += dpp_mov<0x111>(v);
  v += dpp_mov<0x112>(v);
  v += dpp_mov<0x114>(v);
  v += dpp_mov<0x118>(v);
  const float t0 = lane_bcast(v, 15), t1 = lane_bcast(v, 31), t2 = lane_bcast(v, 47);
  return v + ((lane >= 16 ? t0 : 0.f) + (lane >= 32 ? t1 : 0.f) + (lane >= 48 ? t2 : 0.f));
}
__device__ __forceinline__ float xrow_max(float v) {
  unsigned u = __builtin_bit_cast(unsigned, v);
  auto a = __builtin_amdgcn_permlane16_swap(u, u, false, false);
  float m = fmaxf(__builtin_bit_cast(float, a[0]), __builtin_bit_cast(float, a[1]));
  unsigned um = __builtin_bit_cast(unsigned, m);
  auto b2 = __builtin_amdgcn_permlane32_swap(um, um, false, false);
  return fmaxf(__builtin_bit_cast(float, b2[0]), __builtin_bit_cast(float, b2[1]));
}
__device__ __forceinline__ f32x4 mfma16(bf16x8 a, bf16x8 b, f32x4 c) {
  return __builtin_amdgcn_mfma_f32_16x16x32_bf16(a, b, c, 0, 0, 0);
}
__device__ __forceinline__ bf16x8 ldsfrag(const bf16_t* p) { return *(const bf16x8*)p; }


__device__ __forceinline__ int bid_opaque() { int t = blockIdx.x; asm volatile("" : "+s"(t)); return t; }
__device__ __forceinline__ int tid_opaque() { int t = threadIdx.x; asm volatile("" : "+v"(t)); return t; }

__device__ __forceinline__ int first_item(int lo) { int g = (int)gridDim.x; int d = ((int)bid_opaque() - lo) % g; if (d < 0) d += g; return lo + d; }
__device__ __forceinline__ char* wsb(const Params& p) { return p.ws; }
__device__ __forceinline__ int wq_next(int* ctr, char* smem) {
  int* slot = (int*)(smem + LDS_BYTES - 16);
  __syncthreads();
  if (tid_opaque() == 0) *slot = atomicAdd(ctr, 1);
  __syncthreads();
  return __builtin_amdgcn_readfirstlane(*slot);
}

__device__ __forceinline__ const float* inp(const Params& p, int i) { return ((const float* const*)(wsb(p) + OFF_TBL))[i]; }

__device__ __forceinline__ void lds_barrier() { asm volatile("s_waitcnt lgkmcnt(0)\n\ts_barrier" ::: "memory"); }

__device__ __forceinline__ void tok_decode(int tok, int& isc, int& b, int& t) {
  if (tok < NTOK_L) { isc = 0; b = tok >> 12; t = tok & 4095; }
  else { int c = tok - NTOK_L; isc = 1; b = c >> 8; t = c & 255; }
}
__device__ __forceinline__ int chain_tok(int b, int dir, int c, int i) {
  int pos = c * 64 + i;
  if (c < 4) { int t = dir ? (255 - pos) : pos; return NTOK_L + b * 256 + t; }
  int pl = pos - 256; int t = dir ? (4095 - pl) : pl; return b * 4096 + t;
}
__device__ __forceinline__ const float* xrow_src(const Params& p, int l, int tok) {
  if (tok < NTOK_L) return (l == 0 ? inp(p, 0) : p.out) + (size_t)tok * DM;
  return (l == 0 ? inp(p, 2) : (const float*)(wsb(p) + OFF_XC)) + (size_t)(tok - NTOK_L) * DM;
}
__device__ __forceinline__ float* xrow_dst(const Params& p, int tok) {
  if (tok < NTOK_L) return p.out + (size_t)tok * DM;
  return (float*)(wsb(p) + OFF_XC) + (size_t)(tok - NTOK_L) * DM;
}

__device__ __forceinline__ void gemm128(const bf16_t* __restrict__ A, int lda, const bf16_t* __restrict__ Bt, int ldb,
                                        int K, char* smem, f32x4 (&acc)[4][4]) {
  bf16_t* sb0 = (bf16_t*)smem;
  bf16_t* sb1 = sb0 + 2 * 128 * 72;
  const int tid = tid_opaque(), wave = tid >> 6, lane = tid & 63, r = lane & 15, q = lane >> 4;
  const int wr = wave >> 1, wc = wave & 1;
#pragma unroll
  for (int i = 0; i < 4; i++)
#pragma unroll
    for (int j = 0; j < 4; j++) acc[i][j] = f32x4{0.f, 0.f, 0.f, 0.f};
  u32x4 ra0[4], rb0[4], ra1[4], rb1[4];
  const int lrow = tid >> 3, lc8 = (tid & 7) * 8;
  const bf16_t* Ap = A + (size_t)lrow * lda + lc8;
  const bf16_t* Bp = Bt + (size_t)lrow * ldb + lc8;
#define G_LOAD(RA, RB, kt_)                                                         \
  _Pragma("unroll") for (int pz = 0; pz < 4; pz++) {                                \
    RA[pz] = *(const u32x4*)(Ap + (size_t)pz * 32 * lda + (kt_) * 64);              \
    RB[pz] = *(const u32x4*)(Bp + (size_t)pz * 32 * ldb + (kt_) * 64);              \
  }
#define G_STORE(SB, RA, RB)                                                         \
  _Pragma("unroll") for (int pz = 0; pz < 4; pz++) {                                \
    *(u32x4*)((SB) + (pz * 32 + lrow) * 72 + lc8) = RA[pz];                         \
    *(u32x4*)((SB) + 128 * 72 + (pz * 32 + lrow) * 72 + lc8) = RB[pz];              \
  }
#define G_COMPUTE(SB)                                                               \
  _Pragma("unroll") for (int ks = 0; ks < 2; ks++) {                                \
    bf16x8 a[4], b[4];                                                              \
    _Pragma("unroll") for (int i = 0; i < 4; i++) a[i] = ldsfrag((SB) + (wr * 64 + i * 16 + r) * 72 + ks * 32 + q * 8);            \
    _Pragma("unroll") for (int j = 0; j < 4; j++) b[j] = ldsfrag((SB) + 128 * 72 + (wc * 64 + j * 16 + r) * 72 + ks * 32 + q * 8); \
    _Pragma("unroll") for (int i = 0; i < 4; i++)                                   \
      _Pragma("unroll") for (int j = 0; j < 4; j++) acc[i][j] = mfma16(b[j], a[i], acc[i][j]); \
  }
  const int nk = K >> 6;
  G_LOAD(ra0, rb0, 0)
  G_LOAD(ra1, rb1, 1)
  G_STORE(sb0, ra0, rb0)
  G_LOAD(ra0, rb0, 2)
  lds_barrier();
  for (int kt = 0; kt < nk; kt += 2) {
    G_COMPUTE(sb0)
    G_STORE(sb1, ra1, rb1)
    if (kt + 3 < nk) { G_LOAD(ra1, rb1, kt + 3) }
    lds_barrier();
    G_COMPUTE(sb1)
    if (kt + 2 < nk) {
      G_STORE(sb0, ra0, rb0)
      if (kt + 4 < nk) { G_LOAD(ra0, rb0, kt + 4) }
    }
    lds_barrier();
  }
#undef G_LOAD
#undef G_STORE
#undef G_COMPUTE
}

__device__ __forceinline__ void ctile_stage_bf16(char* smem, const f32x4 (&acc)[4][4]) {
  bf16_t* Cs = (bf16_t*)smem;
  const int tid = tid_opaque(), wave = tid >> 6, lane = tid & 63, r = lane & 15, q = lane >> 4;
  const int wr = wave >> 1, wc = wave & 1;
#pragma unroll
  for (int i = 0; i < 4; i++)
#pragma unroll
    for (int j = 0; j < 4; j++)
      *(u32x2*)(Cs + (wr * 64 + i * 16 + r) * 136 + wc * 64 + j * 16 + q * 4) = pack4(acc[i][j]);
  lds_barrier();
}
__device__ __forceinline__ void ctile_store_rows(char* smem, bf16_t* __restrict__ dst, int ld, int ncols) {
  const bf16_t* Cs = (const bf16_t*)smem;
  const int tid = tid_opaque();
#pragma unroll
  for (int c = 0; c < 8; c++) {
    int ch = tid + 256 * c, row = ch >> 4, c8 = (ch & 15) * 8;
    if (c8 < ncols) *(u32x4*)(dst + (size_t)row * ld + c8) = *(const u32x4*)(Cs + row * 136 + c8);
  }
}
template <class F>
__device__ __forceinline__ void ctile_store_transposed(char* smem, F dstT) {
  const bf16_t* Cs = (const bf16_t*)smem;
  const int tid = tid_opaque();
#pragma unroll
  for (int c = 0; c < 8; c++) {
    int ch = tid + 256 * c, n = ch & 127, m8 = ch >> 7;
    bf16_t* d = dstT(n);
    if (d) {
      u32x4 v;
#pragma unroll
      for (int k = 0; k < 4; k++)
        v[k] = (unsigned)Cs[(m8 * 8 + 2 * k) * 136 + n] | ((unsigned)Cs[(m8 * 8 + 2 * k + 1) * 136 + n] << 16);
      *(u32x4*)(d + m8 * 8) = v;
    }
  }
}

__device__ __forceinline__ void gemm128x256(const bf16_t* __restrict__ A, int lda, const bf16_t* __restrict__ Bt, int ldb,
                                            int K, char* smem, f32x4 (&acc)[4][8]) {
  constexpr int STB = 384 * 64;
  const int tid = tid_opaque(), wave = tid >> 6, lane = tid & 63, r = lane & 15, q = lane >> 4;
  const int wr = wave >> 1, wc = wave & 1;
#pragma unroll
  for (int i = 0; i < 4; i++)
#pragma unroll
    for (int j = 0; j < 8; j++) acc[i][j] = f32x4{0.f, 0.f, 0.f, 0.f};
  const bf16_t* gsrc[6];
#pragma unroll
  for (int i = 0; i < 6; i++) {
    int row = (wave + 4 * i) * 16 + (lane >> 2);
    int c = (lane & 3) ^ ((row >> 2) & 3);
    gsrc[i] = (i < 2) ? A + (size_t)row * lda + c * 8 : Bt + (size_t)(row - 128) * ldb + c * 8;
  }
  const int ldsl = wave * 1024 + lane * 16;
#define D_ISSUE(kt_, ST)                                                              \
  {                                                                                   \
    char* sb_ = smem + (ST) * STB + ldsl;                                             \
    _Pragma("unroll") for (int i = 0; i < 6; i++)                                     \
      __builtin_amdgcn_global_load_lds((const unsigned*)(gsrc[i] + (kt_) * 32), (unsigned*)(sb_ + i * 4096), 16, 0, 0); \
  }
  const int nk = K >> 5;
  const int sw = (q ^ (r >> 2)) * 16;
  D_ISSUE(0, 0)
  D_ISSUE(1, 1)
  int st = 0;
  for (int kt = 0; kt < nk; kt++) {
    asm volatile("s_waitcnt vmcnt(6)" ::: "memory");
    lds_barrier();
    const char* sb = smem + st * STB;
    bf16x8 a[4], b[8];
#pragma unroll
    for (int i = 0; i < 4; i++) a[i] = *(const bf16x8*)(sb + (wr * 64 + i * 16 + r) * 64 + sw);
#pragma unroll
    for (int j = 0; j < 8; j++) b[j] = *(const bf16x8*)(sb + (128 + wc * 128 + j * 16 + r) * 64 + sw);
    __builtin_amdgcn_sched_barrier(0);
    {
      int st2 = st + 2; if (st2 >= 3) st2 -= 3;
      int kn = min(kt + 2, nk - 1);
      D_ISSUE(kn, st2)
    }
    __builtin_amdgcn_sched_barrier(0);
    __builtin_amdgcn_s_setprio(1);
#pragma unroll
    for (int i = 0; i < 4; i++)
#pragma unroll
      for (int j = 0; j < 8; j++) acc[i][j] = mfma16(b[j], a[i], acc[i][j]);
    __builtin_amdgcn_s_setprio(0);
    st = (st == 2) ? 0 : st + 1;
  }
#undef D_ISSUE
  asm volatile("s_waitcnt vmcnt(0)" ::: "memory");
  lds_barrier();
}
__device__ __forceinline__ void ctile256_stage_bf16(char* smem, const f32x4 (&acc)[4][8]) {
  bf16_t* Cs = (bf16_t*)smem;
  const int tid = tid_opaque(), wave = tid >> 6, lane = tid & 63, r = lane & 15, q = lane >> 4;
  const int wr = wave >> 1, wc = wave & 1;
#pragma unroll
  for (int i = 0; i < 4; i++)
#pragma unroll
    for (int j = 0; j < 8; j++)
      *(u32x2*)(Cs + (wr * 64 + i * 16 + r) * 264 + wc * 128 + j * 16 + q * 4) = pack4(acc[i][j]);
  lds_barrier();
}
__device__ __forceinline__ void ctile256_store_rows(char* smem, bf16_t* __restrict__ dst, int ld, int c0, int ncols) {
  const bf16_t* Cs = (const bf16_t*)smem;
  const int tid = tid_opaque();
#pragma unroll
  for (int c = 0; c < 16; c++) {
    int ch = tid + 256 * c, row = ch >> 5, c8 = (ch & 31) * 8;
    if (c8 >= c0 && c8 < c0 + ncols) *(u32x4*)(dst + (size_t)row * ld + c8) = *(const u32x4*)(Cs + row * 264 + c8);
  }
}
template <class F>
__device__ __forceinline__ void ctile256_store_transposed(char* smem, F dstT) {
  const bf16_t* Cs = (const bf16_t*)smem;
  const int tid = tid_opaque();
#pragma unroll
  for (int c = 0; c < 16; c++) {
    int ch = tid + 256 * c, n = ch & 255, m8 = ch >> 8;
    bf16_t* d = dstT(n);
    if (d) {
      u32x4 v;
#pragma unroll
      for (int k = 0; k < 4; k++)
        v[k] = (unsigned)Cs[(m8 * 8 + 2 * k) * 264 + n] | ((unsigned)Cs[(m8 * 8 + 2 * k + 1) * 264 + n] << 16);
      *(u32x4*)(d + m8 * 8) = v;
    }
  }
}

__device__ __forceinline__ void transpose_tile(const float* __restrict__ W, int K, int N, bf16_t* __restrict__ Wt, int k0, int n0, char* smem) {
  float* lds = (float*)smem;
  const int tid = tid_opaque();
  f32x4 v[16];
  const int n4 = (tid & 63) * 4;
#pragma unroll
  for (int i = 0; i < 16; i++) {
    int kk = i * 4 + (tid >> 6);
    v[i] = (n0 + n4 < N) ? *(const f32x4*)(W + (size_t)(k0 + kk) * N + n0 + n4) : f32x4{0.f, 0.f, 0.f, 0.f};
  }
#pragma unroll
  for (int i = 0; i < 16; i++) {
    int kk = i * 4 + (tid >> 6);
#pragma unroll
    for (int e = 0; e < 4; e++) lds[kk * 257 + n4 + e] = v[i][e];
  }
  __syncthreads();
  const int k8 = (tid & 7) * 8;
#pragma unroll
  for (int pz = 0; pz < 8; pz++) {
    int n = (tid >> 3) + 32 * pz;
    u32x4 o;
#pragma unroll
    for (int e = 0; e < 4; e++) o[e] = pack2(lds[(k8 + 2 * e) * 257 + n], lds[(k8 + 2 * e + 1) * 257 + n]);
    *(u32x4*)(Wt + (size_t)(n0 + n) * K + k0 + k8) = o;
  }
  __syncthreads();
}

__device__ __forceinline__ void phase0(const Params& p, char* smem) {
  constexpr int N_A = NL * 32 * 27, N_B = NL * 32 * 8, N_C = NL * 6 * 3, N_D = NL * 4 * 4, N_E = NL * 24 * 16;
  constexpr int NT = N_A + N_B + N_C + N_D + N_E;
  for (int it = bid_opaque(); it < NT; it += gridDim.x) {
    int i = it;
    if (i < N_A) {
      int l = i / (32 * 27), rem = i % (32 * 27), kt = rem / 27, nt = rem % 27;
      transpose_tile(inp(p, 7) + (size_t)l * DM * DIN, DM, DIN, (bf16_t*)(wsb(p) + OFF_WIN) + (size_t)l * DINP * DM, kt * 64, nt * 256, smem);
      continue;
    }
    i -= N_A;
    if (i < N_B) {
      int l = i / 256, rem = i % 256, kt = rem / 8, nt = rem % 8;
      transpose_tile(inp(p, 27) + (size_t)l * DM * DM, DM, DM, (bf16_t*)(wsb(p) + OFF_WOUT) + (size_t)l * DM * DM, kt * 64, nt * 256, smem);
      continue;
    }
    i -= N_B;
    if (i < N_C) {
      int l = i / 18, rem = i % 18, kt = rem / 3, nt = rem % 3;
      transpose_tile(inp(p, 16) + (size_t)l * 384 * 768, 384, 768, (bf16_t*)(wsb(p) + OFF_WUQ) + (size_t)l * 768 * 384, kt * 64, nt * 256, smem);
      continue;
    }
    i -= N_C;
    if (i < N_D) {
      int l = i / 16, rem = i % 16, kt = rem / 4, nt = rem % 4;
      transpose_tile(inp(p, 18) + (size_t)l * 256 * 1024, 256, 1024, (bf16_t*)(wsb(p) + OFF_WUKV) + (size_t)l * 1024 * 256, kt * 64, nt * 256, smem);
      continue;
    }
    i -= N_D;
    {
      int l = i / (24 * 16), rem = i % (24 * 16), jb = rem / 16, ks = rem % 16;
      float* sc = (float*)smem;
      const int tid = tid_opaque();
      for (int e = tid; e < 5 * 128; e += 256) {
        int rr = e >> 7, k = e & 127;
        float cv = (rr < 4) ? inp(p, 1)[rr * DM + ks * 128 + k] : inp(p, 3)[ks * 128 + k];
        sc[e] = siluf(cv);
      }
      __syncthreads();
      const float* w = inp(p, 5) + (size_t)l * DM * 6144 + (size_t)(ks * 128) * 6144 + jb * 256 + tid;
      float a0 = 0, a1 = 0, a2 = 0, a3 = 0, a4 = 0;
#pragma unroll 16
      for (int k = 0; k < 128; k++) {
        float wv = w[(size_t)k * 6144];
        a0 += sc[k] * wv; a1 += sc[128 + k] * wv; a2 += sc[256 + k] * wv; a3 += sc[384 + k] * wv; a4 += sc[512 + k] * wv;
      }
      float* pm = (float*)(wsb(p) + OFF_PM) + (size_t)((l * 16 + ks) * 5) * 6144 + jb * 256 + tid;
      pm[0] = a0; pm[6144] = a1; pm[2 * 6144] = a2; pm[3 * 6144] = a3; pm[4 * 6144] = a4;
      __syncthreads();
    }
  }
}

__device__ __forceinline__ void phase_modred(const Params& p) {
  const int n = NL * 5 * 6144;
  for (int i = bid_opaque() * 256 + tid_opaque(); i < n; i += gridDim.x * 256) {
    int l = i / (5 * 6144), rem = i % (5 * 6144), rr = rem / 6144, j = rem % 6144;
    float s = inp(p, 6)[l * 6144 + j];
    const float* pm = (const float*)(wsb(p) + OFF_PM) + (size_t)(l * 16 * 5 + rr) * 6144 + j;
#pragma unroll
    for (int ks = 0; ks < 16; ks++) s += pm[(size_t)ks * 5 * 6144];
    ((float*)(wsb(p) + OFF_MOD))[i] = s;
  }
}

__device__ __forceinline__ void phase_norm(const Params& p, int l) {
  const int wave = tid_opaque() >> 6, lane = tid_opaque() & 63;
  bf16_t* H = (bf16_t*)(wsb(p) + OFF_H);
  const float* nw = inp(p, 4) + l * DM;
  const int nit = NTOK / 4, gstep = gridDim.x;
  f32x4 w4[8];
#pragma unroll
  for (int i = 0; i < 8; i++) w4[i] = *(const f32x4*)(nw + (lane + 64 * i) * 4);
  f32x4 v[8], nv[8];
  int it = bid_opaque();
  if (it < nit) {
    const f32x4* src = (const f32x4*)xrow_src(p, l, it * 4 + wave);
#pragma unroll
    for (int i = 0; i < 8; i++) v[i] = src[lane + 64 * i];
  }
  for (; it < nit; it += gstep) {
    const int tok = it * 4 + wave;
    const bool more = it + gstep < nit;
    if (more) {
      const f32x4* src = (const f32x4*)xrow_src(p, l, (it + gstep) * 4 + wave);
#pragma unroll
      for (int i = 0; i < 8; i++) nv[i] = src[lane + 64 * i];
    }
    int isc, b, t; tok_decode(tok, isc, b, t);
    const float* mod = (const float*)(wsb(p) + OFF_MOD) + (size_t)(l * 5 + (isc ? 4 : b)) * 6144;
    f32x4 sh[8], sc[8];
#pragma unroll
    for (int i = 0; i < 8; i++) {
      int col = (lane + 64 * i) * 4;
      sh[i] = *(const f32x4*)(mod + col);
      sc[i] = *(const f32x4*)(mod + 2048 + col);
    }
    float ss = 0.f;
#pragma unroll
    for (int i = 0; i < 8; i++) ss += v[i][0] * v[i][0] + v[i][1] * v[i][1] + v[i][2] * v[i][2] + v[i][3] * v[i][3];
    ss = wave_sum(ss);
    float rstd = rsqrtf(ss * (1.f / DM) + EPS);
#pragma unroll
    for (int i = 0; i < 8; i++) {
      int col = (lane + 64 * i) * 4;
      f32x4 o = v[i] * rstd * w4[i] * (sc[i] + 1.f) + sh[i];
      *(u32x2*)(H + (size_t)tok * DM + col) = pack4(o);
    }
    if (more) {
#pragma unroll
      for (int i = 0; i < 8; i++) v[i] = nv[i];
    }
  }
}

__device__ __forceinline__ void phase_inproj(const Params& p, int l, char* smem) {
  const bf16_t* H = (const bf16_t*)(wsb(p) + OFF_H);
  const bf16_t* W = (const bf16_t*)(wsb(p) + OFF_WIN) + (size_t)l * DINP * DM;
  bf16_t* PROJ = (bf16_t*)(wsb(p) + OFF_PROJ);
  float* PSM = (float*)(wsb(p) + OFF_PSM);
  bf16_t* NVTL = (bf16_t*)(wsb(p) + OFF_NVTL);
  bf16_t* NVTC = (bf16_t*)(wsb(p) + OFF_NVTC);
  const int xcd = bid_opaque() & 7, lb = bid_opaque() >> 3, nlb = (int)gridDim.x >> 3;
  const int ntot = 17 * 27, nbig = (ntot / nlb) * nlb;
  for (int j = lb; j < nbig; j += nlb) {
    int mi, nt;
    { int g = j / 51, rem = j - g * 51; mi = rem / 3; nt = g * 3 + (rem - mi * 3); }
    int mt = xcd + 8 * mi;
    int m0 = mt * 128, n0 = nt * 256;
    int isc, b, t0; tok_decode(m0, isc, b, t0);
    f32x4 acc[4][8];
    gemm128x256(H + (size_t)m0 * DM, DM, W + (size_t)n0 * DM, DM, DM, smem, acc);
    if (nt == 8 || nt == 26) {
      const int tid = tid_opaque(), wave = tid >> 6, lane = tid & 63, r = lane & 15, q = lane >> 4;
      const int wr = wave >> 1, wc = wave & 1;
      const int cbase = (nt == 8) ? C_GBETA : C_SDT, pofs = (nt == 8) ? 0 : 16;
#pragma unroll
      for (int i = 0; i < 4; i++)
#pragma unroll
        for (int j2 = 0; j2 < 8; j2++)
#pragma unroll
          for (int e = 0; e < 4; e++) {
            int gcol = n0 + wc * 128 + j2 * 16 + q * 4 + e;
            if (gcol >= cbase && gcol < cbase + 16) PSM[(size_t)(m0 + wr * 64 + i * 16 + r) * 32 + pofs + gcol - cbase] = acc[i][j2][e];
          }
    }
    ctile256_stage_bf16(smem, acc);
    ctile256_store_rows(smem, PROJ + (size_t)m0 * DIN + n0, DIN, 0, min(256, DIN - n0));
    if (nt >= 12 && nt <= 14) {
      ctile256_store_transposed(smem, [&](int n) -> bf16_t* {
        int gcol = n0 + n;
        if (gcol < C_NQKV + 1024 || gcol >= C_NQKV + 1536) return nullptr;
        int hh = (gcol - (C_NQKV + 1024)) >> 7, d = (gcol - (C_NQKV + 1024)) & 127;
        return isc ? NVTC + ((size_t)((b * 4 + hh) * 128 + d)) * TC + t0 : NVTL + ((size_t)((b * 4 + hh) * 128 + d)) * TL + t0;
      });
    }
    __syncthreads();
  }
  for (int sidx = lb; sidx < (ntot - nbig) * 2; sidx += nlb) {
    int j = nbig + (sidx >> 1), hf2 = sidx & 1;
    int mi, nt;
    { int g = j / 51, rem = j - g * 51; mi = rem / 3; nt = g * 3 + (rem - mi * 3); }
    int mt = xcd + 8 * mi;
    int m0 = mt * 128, n0 = nt * 256 + hf2 * 128;
    f32x4 acc[4][4];
    gemm128(H + (size_t)m0 * DM, DM, W + (size_t)n0 * DM, DM, DM, smem, acc);
    if (n0 <= C_SDT && C_SDT < n0 + 128) {
      const int tid = tid_opaque(), wave = tid >> 6, lane = tid & 63, r = lane & 15, q = lane >> 4;
      const int wr = wave >> 1, wc = wave & 1;
#pragma unroll
      for (int i = 0; i < 4; i++)
#pragma unroll
        for (int j2 = 0; j2 < 4; j2++)
#pragma unroll
          for (int e = 0; e < 4; e++) {
            int gcol = n0 + wc * 64 + j2 * 16 + q * 4 + e;
            if (gcol >= C_SDT && gcol < C_SDT + 16) PSM[(size_t)(m0 + wr * 64 + i * 16 + r) * 32 + 16 + gcol - C_SDT] = acc[i][j2][e];
          }
    }
    ctile_stage_bf16(smem, acc);
    if (n0 < DIN) ctile_store_rows(smem, PROJ + (size_t)m0 * DIN + n0, DIN, min(128, DIN - n0));
    __syncthreads();
  }
}

__device__ __forceinline__ void phase_prep(const Params& p, int l) {
  const int wave = tid_opaque() >> 6, lane = tid_opaque() & 63;
  const bf16_t* PROJ = (const bf16_t*)(wsb(p) + OFF_PROJ);
  const float* PSM = (const float*)(wsb(p) + OFF_PSM);
  const int nit = NTOK / 4, gstep = gridDim.x;
  {
    bf16_t* GQ = (bf16_t*)(wsb(p) + OFF_GQ);
    bf16_t* GK = (bf16_t*)(wsb(p) + OFF_GK);
    bf16_t* GV = (bf16_t*)(wsb(p) + OFF_GV);
    float* GG = (float*)(wsb(p) + OFF_GG);
    float* GBETA = (float*)(wsb(p) + OFF_GBETA);
    const float* gcw = inp(p, 8) + (size_t)l * 3 * 1536;
    float2 w0[12], w1[12], w2[12];
#pragma unroll
    for (int wh = 0; wh < 12; wh++) {
      int c = (wh >> 2) * 512 + (wh & 3) * 128 + lane * 2;
      w0[wh] = *(const float2*)(gcw + c); w1[wh] = *(const float2*)(gcw + 1536 + c); w2[wh] = *(const float2*)(gcw + 3072 + c);
    }
    const float alog = (lane < 8) ? inp(p, 9)[l * 8 + lane] : 0.f;
    const float dtb = (lane < 8) ? inp(p, 10)[l * 8 + lane] : 0.f;
    unsigned g0[12], g1[12], g2[12], n0[12], n1[12], n2[12];
    float bi = 0.f, ai = 0.f, nbi = 0.f, nai = 0.f;
#define PREP1_LOAD(TOK, A0, A1, A2, BI, AI)                                                      \
    {                                                                                            \
      int isc_, b_, t_; tok_decode((TOK), isc_, b_, t_);                                         \
      const bf16_t* P0 = PROJ + (size_t)(TOK) * DIN;                                             \
      const bool hasm = t_ > 0, hasp = t_ < (isc_ ? TC : TL) - 1;                                \
      _Pragma("unroll") for (int wh = 0; wh < 12; wh++) {                                        \
        int c = (wh >> 2) * 512 + (wh & 3) * 128 + lane * 2;                                     \
        A1[wh] = *(const unsigned*)(P0 + C_GQKV + c);                                            \
        A0[wh] = hasm ? *(const unsigned*)(P0 - DIN + C_GQKV + c) : 0u;                          \
        A2[wh] = hasp ? *(const unsigned*)(P0 + DIN + C_GQKV + c) : 0u;                          \
      }                                                                                          \
      if (lane < 8) { BI = PSM[(size_t)(TOK) * 32 + lane]; AI = PSM[(size_t)(TOK) * 32 + 8 + lane]; } \
    }
    int it = bid_opaque();
    if (it < nit) PREP1_LOAD(it * 4 + wave, g0, g1, g2, bi, ai)
    for (; it < nit; it += gstep) {
      const int tok = it * 4 + wave;
      const bool more = it + gstep < nit;
      if (more) PREP1_LOAD((it + gstep) * 4 + wave, n0, n1, n2, nbi, nai)
#pragma unroll
      for (int wh = 0; wh < 12; wh++) {
        int which = wh >> 2, h = wh & 3;
        float ya = siluf(w0[wh].x * lo2f(g0[wh]) + w1[wh].x * lo2f(g1[wh]) + w2[wh].x * lo2f(g2[wh]));
        float yb = siluf(w0[wh].y * hi2f(g0[wh]) + w1[wh].y * hi2f(g1[wh]) + w2[wh].y * hi2f(g2[wh]));
        if (which < 2) {
          float ss = wave_sum(ya * ya + yb * yb);
          float rn = rsqrtf(ss + EPS);
          if (which == 0) rn *= 0.08838834764831845f;
          ya *= rn; yb *= rn;
        }
        bf16_t* dst = (which == 0 ? GQ : (which == 1 ? GK : GV)) + (size_t)tok * 512 + h * 128 + lane * 2;
        *(unsigned*)dst = pack2(ya, yb);
      }
      if (lane < 8) {
        int dir = lane >> 2, h = lane & 3;
        float beta = 1.f / (1.f + __expf(-bi));
        float g = -__expf(alog) * softplusf(ai + dtb);
        GBETA[((size_t)dir * NTOK + tok) * 4 + h] = beta;
        GG[((size_t)dir * NTOK + tok) * 4 + h] = g;
      }
      if (more) {
#pragma unroll
        for (int wh = 0; wh < 12; wh++) { g0[wh] = n0[wh]; g1[wh] = n1[wh]; g2[wh] = n2[wh]; }
        bi = nbi; ai = nai;
      }
    }
#undef PREP1_LOAD
  }
  {
    bf16_t* NQ = (bf16_t*)(wsb(p) + OFF_NQ);
    bf16_t* NK = (bf16_t*)(wsb(p) + OFF_NK);
    bf16_t* CQN = (bf16_t*)(wsb(p) + OFF_CQN);
    bf16_t* CKVN = (bf16_t*)(wsb(p) + OFF_CKVN);
    const float2 nwq = *(const float2*)(inp(p, 12) + l * 128 + lane * 2);
    const float2 nwk = *(const float2*)(inp(p, 13) + l * 128 + lane * 2);
    float2 qaw[3], kvw[2];
#pragma unroll
    for (int i = 0; i < 3; i++) qaw[i] = *(const float2*)(inp(p, 15) + l * 384 + lane * 2 + 128 * i);
#pragma unroll
    for (int i = 0; i < 2; i++) kvw[i] = *(const float2*)(inp(p, 17) + l * 256 + lane * 2 + 128 * i);
    unsigned cu[13], nu[13];
#define PREP2_LOAD(TOK, U)                                                                       \
    {                                                                                            \
      const bf16_t* P0 = PROJ + (size_t)(TOK) * DIN;                                             \
      _Pragma("unroll") for (int wh = 0; wh < 8; wh++) U[wh] = *(const unsigned*)(P0 + C_NQKV + (wh >> 2) * 512 + (wh & 3) * 128 + lane * 2); \
      _Pragma("unroll") for (int i = 0; i < 3; i++) U[8 + i] = *(const unsigned*)(P0 + C_MQ + lane * 2 + 128 * i);   \
      _Pragma("unroll") for (int i = 0; i < 2; i++) U[11 + i] = *(const unsigned*)(P0 + C_MKV + lane * 2 + 128 * i); \
    }
    int it = bid_opaque();
    if (it < nit) PREP2_LOAD(it * 4 + wave, cu)
    for (; it < nit; it += gstep) {
      const int tok = it * 4 + wave;
      const bool more = it + gstep < nit;
      if (more) PREP2_LOAD((it + gstep) * 4 + wave, nu)
#pragma unroll
      for (int wh = 0; wh < 8; wh++) {
        int which = wh >> 2, h = wh & 3;
        float xa = lo2f(cu[wh]), xb = hi2f(cu[wh]);
        float ss = wave_sum(xa * xa + xb * xb);
        float rn = rsqrtf(ss * (1.f / 128.f) + EPS);
        float2 nw = which ? nwk : nwq;
        bf16_t* dst = (which == 0 ? NQ : NK) + (size_t)tok * 512 + h * 128 + lane * 2;
        *(unsigned*)dst = pack2(xa * rn * nw.x, xb * rn * nw.y);
      }
      {
        float ss = 0.f;
#pragma unroll
        for (int i = 0; i < 3; i++) { float xa = lo2f(cu[8 + i]), xb = hi2f(cu[8 + i]); ss += xa * xa + xb * xb; }
        ss = wave_sum(ss);
        float rn = rsqrtf(ss * (1.f / 384.f) + EPS);
#pragma unroll
        for (int i = 0; i < 3; i++)
          *(unsigned*)(CQN + (size_t)tok * 384 + lane * 2 + 128 * i) = pack2(lo2f(cu[8 + i]) * rn * qaw[i].x, hi2f(cu[8 + i]) * rn * qaw[i].y);
      }
      {
        float ss = 0.f;
#pragma unroll
        for (int i = 0; i < 2; i++) { float xa = lo2f(cu[11 + i]), xb = hi2f(cu[11 + i]); ss += xa * xa + xb * xb; }
        ss = wave_sum(ss);
        float rn = rsqrtf(ss * (1.f / 256.f) + EPS);
#pragma unroll
        for (int i = 0; i < 2; i++)
          *(unsigned*)(CKVN + (size_t)tok * 256 + lane * 2 + 128 * i) = pack2(lo2f(cu[11 + i]) * rn * kvw[i].x, hi2f(cu[11 + i]) * rn * kvw[i].y);
      }
      if (more) {
#pragma unroll
        for (int i = 0; i < 13; i++) cu[i] = nu[i];
      }
    }
#undef PREP2_LOAD
  }
  {
    bf16_t* SX = (bf16_t*)(wsb(p) + OFF_SX);
    bf16_t* SB = (bf16_t*)(wsb(p) + OFF_SB);
    bf16_t* SC = (bf16_t*)(wsb(p) + OFF_SC);
    float* SDT = (float*)(wsb(p) + OFF_SDT);
    const float* scw = inp(p, 21) + (size_t)l * 3 * 1024;
    const float* scb = inp(p, 22) + (size_t)l * 1024;
    float2 w0[8], w1[8], w2[8], bb[8];
#pragma unroll
    for (int i = 0; i < 8; i++) {
      int c = lane * 2 + 128 * i;
      w0[i] = *(const float2*)(scw + c); w1[i] = *(const float2*)(scw + 1024 + c); w2[i] = *(const float2*)(scw + 2048 + c);
      bb[i] = *(const float2*)(scb + c);
    }
    const float dtb = (lane < 16) ? inp(p, 24)[l * 16 + lane] : 0.f;
    unsigned s0[8], s1[8], s2[8], n0[8], n1[8], n2[8];
    float dti = 0.f, ndti = 0.f;
#define PREP3_LOAD(TOK, A0, A1, A2, DTI)                                                         \
    {                                                                                            \
      int isc_, b_, t_; tok_decode((TOK), isc_, b_, t_);                                         \
      const bf16_t* P0 = PROJ + (size_t)(TOK) * DIN;                                             \
      const bool hasm = t_ > 0, hasp = t_ < (isc_ ? TC : TL) - 1;                                \
      _Pragma("unroll") for (int i = 0; i < 8; i++) {                                            \
        int c = lane * 2 + 128 * i;                                                              \
        A1[i] = *(const unsigned*)(P0 + C_SXBC + c);                                             \
        A0[i] = hasm ? *(const unsigned*)(P0 - DIN + C_SXBC + c) : 0u;                           \
        A2[i] = hasp ? *(const unsigned*)(P0 + DIN + C_SXBC + c) : 0u;                           \
      }                                                                                          \
      if (lane < 16) DTI = PSM[(size_t)(TOK) * 32 + 16 + lane];                                  \
    }
    int it = bid_opaque();
    if (it < nit) PREP3_LOAD(it * 4 + wave, s0, s1, s2, dti)
    for (; it < nit; it += gstep) {
      const int tok = it * 4 + wave;
      const bool more = it + gstep < nit;
      if (more) PREP3_LOAD((it + gstep) * 4 + wave, n0, n1, n2, ndti)
#pragma unroll
      for (int i = 0; i < 8; i++) {
        int c = lane * 2 + 128 * i;
        float ya = siluf(w0[i].x * lo2f(s0[i]) + w1[i].x * lo2f(s1[i]) + w2[i].x * lo2f(s2[i]) + bb[i].x);
        float yb = siluf(w0[i].y * hi2f(s0[i]) + w1[i].y * hi2f(s1[i]) + w2[i].y * hi2f(s2[i]) + bb[i].y);
        bf16_t* dst = (i < 4) ? SX + (size_t)tok * 512 + c : (i < 6 ? SB + (size_t)tok * 256 + (c - 512) : SC + (size_t)tok * 256 + (c - 768));
        *(unsigned*)dst = pack2(ya, yb);
      }
      if (lane < 16) SDT[(size_t)tok * 16 + lane] = softplusf(dti + dtb);
      if (more) {
#pragma unroll
        for (int i = 0; i < 8; i++) { s0[i] = n0[i]; s1[i] = n1[i]; s2[i] = n2[i]; }
        dti = ndti;
      }
    }
#undef PREP3_LOAD
  }
}

__device__ __forceinline__ void gdn_chunk_prep(const Params& p, int item, char* smem) {
  bf16_t* Kl = (bf16_t*)smem;
  bf16_t* Ql = Kl + 64 * 136;
  bf16_t* VbT = (bf16_t*)smem;
  bf16_t* KbT = VbT + 128 * 72;
  float* Af = (float*)(smem + 36864);
  bf16_t* Tb = (bf16_t*)Af;
  float* Tf = Af + 64 * 68;
  float* Mt = Tf + 64 * 68;
  float* gaml = Mt + 768;
  float* betal = gaml + 64;
  const int tid = tid_opaque(), wave = tid >> 6, lane = tid & 63, r = lane & 15, q = lane >> 4;
  const int c = item % NCHUNK, dir = (item / NCHUNK) & 1, h = (item / (NCHUNK * 2)) & 3, b = item / (NCHUNK * 8);
  const bf16_t* GQ = (const bf16_t*)(wsb(p) + OFF_GQ);
  const bf16_t* GK = (const bf16_t*)(wsb(p) + OFF_GK);
  const bf16_t* GV = (const bf16_t*)(wsb(p) + OFF_GV);
  const float* GG = (const float*)(wsb(p) + OFF_GG);
  const float* GBETA = (const float*)(wsb(p) + OFF_GBETA);
#pragma unroll
  for (int i = 0; i < 4; i++) {
    int ch = tid + 256 * i, row = ch >> 4, c8 = (ch & 15) * 8;
    int tok = chain_tok(b, dir, c, row);
    size_t go = (size_t)tok * 512 + h * 128 + c8;
    *(u32x4*)(Kl + row * 136 + c8) = *(const u32x4*)(GK + go);
    *(u32x4*)(Ql + row * 136 + c8) = *(const u32x4*)(GQ + go);
  }
  if (wave == 0) {
    int tok = chain_tok(b, dir, c, lane);
    float g = GG[((size_t)dir * NTOK + tok) * 4 + h];
    float be = GBETA[((size_t)dir * NTOK + tok) * 4 + h];
    float gm = wave_incl_scan(g, lane);
    gaml[lane] = gm; betal[lane] = be;
    ((float*)(wsb(p) + OFF_GAM))[(size_t)item * 64 + lane] = gm;
  }
  __syncthreads();
  {
    f32x4 akk[4], aqk[4];
#pragma unroll
    for (int nt = 0; nt < 4; nt++) { akk[nt] = f32x4{0, 0, 0, 0}; aqk[nt] = f32x4{0, 0, 0, 0}; }
#pragma unroll
    for (int ks = 0; ks < 4; ks++) {
      bf16x8 aK = ldsfrag(Kl + (wave * 16 + r) * 136 + ks * 32 + q * 8);
      bf16x8 aQ = ldsfrag(Ql + (wave * 16 + r) * 136 + ks * 32 + q * 8);
#pragma unroll
      for (int nt = 0; nt < 4; nt++) {
        bf16x8 bK = ldsfrag(Kl + (nt * 16 + r) * 136 + ks * 32 + q * 8);
        akk[nt] = mfma16(aK, bK, akk[nt]);
        aqk[nt] = mfma16(aQ, bK, aqk[nt]);
      }
    }
    bf16_t* QKo = (bf16_t*)(wsb(p) + OFF_QK) + (size_t)item * 4096;
#pragma unroll
    for (int nt = 0; nt < 4; nt++)
#pragma unroll
      for (int e = 0; e < 4; e++) {
        int i = wave * 16 + q * 4 + e, j = nt * 16 + r;
        float dec = (j <= i) ? __expf(gaml[i] - gaml[j]) : 0.f;
        Af[i * 68 + j] = (j < i) ? betal[i] * akk[nt][e] * dec : 0.f;
        QKo[i * 64 + j] = f2bf(aqk[nt][e] * dec);
      }
  }
  __syncthreads();
  {
    int tok = chain_tok(b, dir, c, lane);
    float fv = betal[lane], fk = fv * __expf(gaml[lane]);
    const bf16_t* ks_ = GK + (size_t)tok * 512 + h * 128 + wave * 32;
    const bf16_t* vs_ = GV + (size_t)tok * 512 + h * 128 + wave * 32;
#pragma unroll
    for (int i = 0; i < 4; i++) {
      u32x4 kv = *(const u32x4*)(ks_ + i * 8);
      u32x4 vv = *(const u32x4*)(vs_ + i * 8);
      int d0 = wave * 32 + i * 8;
#pragma unroll
      for (int e = 0; e < 4; e++) {
        unsigned pkk = pack2(lo2f(kv[e]) * fk, hi2f(kv[e]) * fk), pkv = pack2(lo2f(vv[e]) * fv, hi2f(vv[e]) * fv);
        KbT[(d0 + 2 * e) * 72 + lane] = (bf16_t)pkk; KbT[(d0 + 2 * e + 1) * 72 + lane] = (bf16_t)(pkk >> 16);
        VbT[(d0 + 2 * e) * 72 + lane] = (bf16_t)pkv; VbT[(d0 + 2 * e + 1) * 72 + lane] = (bf16_t)(pkv >> 16);
      }
    }
  }
  if (tid < 64) {
    int blk = tid >> 4, cc = tid & 15;
    float x[16];
#pragma unroll
    for (int i = 0; i < 16; i++) {
      float acc = (i == cc) ? 1.f : 0.f;
#pragma unroll
      for (int j = 0; j < i; j++) acc -= Af[(16 * blk + i) * 68 + 16 * blk + j] * x[j];
      x[i] = acc;
    }
#pragma unroll
    for (int i = 0; i < 16; i++) Tf[(16 * blk + i) * 68 + 16 * blk + cc] = x[i];
  }
  __syncthreads();
  {
    const int rr = tid >> 4, cc = tid & 15;
#pragma unroll 1
    for (int d = 1; d < 4; d++) {
      for (int bi = 0; bi < 4 - d; bi++) {
        int i = d + bi, j = bi;
        float m = 0.f;
        for (int k = j; k < i; k++)
#pragma unroll
          for (int mm = 0; mm < 16; mm++) m += Af[(16 * i + rr) * 68 + 16 * k + mm] * Tf[(16 * k + mm) * 68 + 16 * j + cc];
        Mt[bi * 256 + rr * 16 + cc] = m;
      }
      __syncthreads();
      for (int bi = 0; bi < 4 - d; bi++) {
        int i = d + bi, j = bi;
        float t = 0.f;
#pragma unroll
        for (int mm = 0; mm < 16; mm++) t -= Tf[(16 * i + rr) * 68 + 16 * i + mm] * Mt[bi * 256 + mm * 16 + cc];
        Tf[(16 * i + rr) * 68 + 16 * j + cc] = t;
      }
      __syncthreads();
    }
  }
#pragma unroll
  for (int k = 0; k < 16; k++) {
    int e = tid + 256 * k, i = e >> 6, j = e & 63;
    float v = ((i >> 4) >= (j >> 4)) ? Tf[i * 68 + j] : 0.f;
    Tb[i * 72 + j] = f2bf(v);
  }
  __syncthreads();
  {
    f32x4 aU[8], aW[8];
#pragma unroll
    for (int nt = 0; nt < 8; nt++) { aU[nt] = f32x4{0, 0, 0, 0}; aW[nt] = f32x4{0, 0, 0, 0}; }
#pragma unroll
    for (int ks = 0; ks < 2; ks++) {
      bf16x8 aT = ldsfrag(Tb + (wave * 16 + r) * 72 + ks * 32 + q * 8);
#pragma unroll
      for (int nt = 0; nt < 8; nt++) {
        aU[nt] = mfma16(aT, ldsfrag(VbT + (nt * 16 + r) * 72 + ks * 32 + q * 8), aU[nt]);
        aW[nt] = mfma16(aT, ldsfrag(KbT + (nt * 16 + r) * 72 + ks * 32 + q * 8), aW[nt]);
      }
    }
    bf16_t* Uo = (bf16_t*)(wsb(p) + OFF_U) + (size_t)item * 8192;
    bf16_t* Wo = (bf16_t*)(wsb(p) + OFF_WNEG) + (size_t)item * 8192;
#pragma unroll
    for (int nt = 0; nt < 8; nt++)
#pragma unroll
      for (int e = 0; e < 4; e++) {
        int i = wave * 16 + q * 4 + e, col = nt * 16 + r;
        Uo[i * 128 + col] = f2bf(aU[nt][e]);
        Wo[i * 128 + col] = f2bf(-aW[nt][e]);
      }
  }
  __syncthreads();
}

__device__ __forceinline__ void phase_mlaup(const Params& p, int l, char* smem, int rep = 0) {
  constexpr int MT = NTOK / 128;
  constexpr int N_Q = MT * 6, N_KV = MT * 8;
  const bf16_t* CQN = (const bf16_t*)(wsb(p) + OFF_CQN);
  const bf16_t* CKVN = (const bf16_t*)(wsb(p) + OFF_CKVN);
  bf16_t* QRAW = (bf16_t*)(wsb(p) + OFF_QRAW);
  bf16_t* KRAW = (bf16_t*)(wsb(p) + OFF_KRAW);
  bf16_t* MVTL = (bf16_t*)(wsb(p) + OFF_MVTL);
  bf16_t* MVTC = (bf16_t*)(wsb(p) + OFF_MVTC);
  const bf16_t* WQ = (const bf16_t*)(wsb(p) + OFF_WUQ) + (size_t)l * 768 * 384;
  const bf16_t* WKV = (const bf16_t*)(wsb(p) + OFF_WUKV) + (size_t)l * 1024 * 256;
  const int xcd = bid_opaque() & 7;
  int* ctr = (int*)(wsb(p) + OFF_WQ) + (l * 8 + xcd) + rep * 128;
  constexpr int NG_X = NGITEM / 8;
  constexpr int NQ_X = 17 * 3, NKV_X = 17 * 4;
  int it = wq_next(ctr, smem);
  while (it < NQ_X) {
    int i = it;
    int mt = xcd + 8 * (i / 3), nt = i % 3, m0 = mt * 128, n0 = nt * 256;
    f32x4 acc[4][8];
    gemm128x256(CQN + (size_t)m0 * 384, 384, WQ + (size_t)n0 * 384, 384, 384, smem, acc);
    ctile256_stage_bf16(smem, acc);
    ctile256_store_rows(smem, QRAW + (size_t)m0 * 768 + n0, 768, 0, 256);
    __syncthreads();
    it = wq_next(ctr, smem);
  }
  while (it < NQ_X + NKV_X) {
    int i = it - NQ_X;
    int mt = xcd + 8 * (i >> 2), hh = i & 3, m0 = mt * 128, n0 = hh * 256;
    int isc, b, t0; tok_decode(m0, isc, b, t0);
    f32x4 acc[4][8];
    gemm128x256(CKVN + (size_t)m0 * 256, 256, WKV + (size_t)n0 * 256, 256, 256, smem, acc);
    ctile256_stage_bf16(smem, acc);
    ctile256_store_rows(smem, KRAW + (size_t)m0 * 512 + hh * 128, 512, 0, 128);
    ctile256_store_transposed(smem, [&](int n) -> bf16_t* {
      if (n < 128) return nullptr;
      int d = n - 128;
      return isc ? MVTC + ((size_t)((b * 4 + hh) * 128 + d)) * TC + t0 : MVTL + ((size_t)((b * 4 + hh) * 128 + d)) * TL + t0;
    });
    __syncthreads();
    it = wq_next(ctr, smem);
  }
  while (it < NQ_X + NKV_X + NG_X) { gdn_chunk_prep(p, xcd * NG_X + (it - NQ_X - NKV_X), smem); it = wq_next(ctr, smem); }
}

__device__ __forceinline__ void phase_prep2(const Params& p, int l) {
  const int wave = tid_opaque() >> 6, lane = tid_opaque() & 63;
  const bf16_t* QRAW = (const bf16_t*)(wsb(p) + OFF_QRAW);
  const bf16_t* KRAW = (const bf16_t*)(wsb(p) + OFF_KRAW);
  const bf16_t* PROJ = (const bf16_t*)(wsb(p) + OFF_PROJ);
  bf16_t* MQ = (bf16_t*)(wsb(p) + OFF_MQ);
  bf16_t* MK = (bf16_t*)(wsb(p) + OFF_MK);
  const float* qn = inp(p, 19) + l * 192;
  const float* kn = inp(p, 20) + l * 192;
  const int f = lane & 15;
  const float inv_freq = exp2f(-(float)f * (13.287712379549449f / 16.f));
  const bool second = (lane & 16) != 0;
  for (int it = bid_opaque(); it < NTOK / 4; it += gridDim.x) {
    int tok = it * 4 + wave;
    int isc, b, t; tok_decode(tok, isc, b, t);
    float pos = (lane < 32) ? (float)(t >> 6) : (float)(t & 63);
    float ang = pos * inv_freq;
    float cs = __cosf(ang), sn = __sinf(ang);
    float krv = bf2f(PROJ[(size_t)tok * DIN + C_MKR + lane]);
    float xq[4][3], xk[4][2];
#pragma unroll
    for (int h = 0; h < 4; h++) {
      const bf16_t* sq = QRAW + (size_t)tok * 768 + h * 192;
      const bf16_t* sk = KRAW + (size_t)tok * 512 + h * 128;
      xq[h][0] = bf2f(sq[lane]); xq[h][1] = bf2f(sq[lane + 64]); xq[h][2] = bf2f(sq[lane + 128]);
      xk[h][0] = bf2f(sk[lane]); xk[h][1] = bf2f(sk[lane + 64]);
    }
    const float qn0 = qn[lane], qn1 = qn[lane + 64], qn2 = qn[lane + 128];
    const float kn0 = kn[lane], kn1 = kn[lane + 64], kn2 = kn[lane + 128];
#pragma unroll
    for (int h = 0; h < 4; h++) {
#pragma unroll
      for (int isk = 0; isk < 2; isk++) {
        float x0 = isk ? xk[h][0] : xq[h][0], x1 = isk ? xk[h][1] : xq[h][1], x2 = isk ? krv : xq[h][2];
        float ss = wave_sum(x0 * x0 + x1 * x1 + x2 * x2);
        float rn = rsqrtf(ss * (1.f / 192.f) + EPS);
        x0 *= rn * (isk ? kn0 : qn0); x1 *= rn * (isk ? kn1 : qn1); x2 *= rn * (isk ? kn2 : qn2);
        if (!isc) {
          float other = __shfl_xor(x2, 16);
          x2 = second ? (x2 * cs + other * sn) : (x2 * cs - other * sn);
        }
        bf16_t* d = (isk ? MK : MQ) + (size_t)tok * 768 + h * 192;
        d[lane] = f2bf(x0); d[lane + 64] = f2bf(x1); d[lane + 128] = f2bf(x2);
      }
    }
  }
}

struct KSeg { const bf16_t* k; const bf16_t* vt; int vt_stride; int n; };

template <int DQ, int MT, bool NA>
__device__ __forceinline__ void attn_item(char* smem, const bf16_t* __restrict__ qptr, int qstride, KSeg s0, KSeg s1, int kstride, float scale,
                          const float* __restrict__ rpb_h, int rr, int row0,
                          const bf16_t* __restrict__ zptr, bf16_t* __restrict__ optr, bool enabled) {
  constexpr int KS = DQ + 8, KSB = KS * 2;
  constexpr int KIMG = 32 * KSB;
  constexpr int NKI = (KIMG + 1023) / 1024;
  constexpr int KREG = NKI * 1024;
  constexpr int VS = 40, VSB = 80, NVI = 10, VREG = 10240;
  constexpr int STAGE = KREG + VREG;
  constexpr int NTOT = NKI + NVI;
  constexpr int NIW = (NTOT + 3) / 4;
  static_assert(3 * STAGE + 1024 + 2048 <= LDS_BYTES - 16, "attention LDS");
  char* dump = smem + 3 * STAGE;
  float* rpbl = (float*)(dump + 1024);
  const int tid = tid_opaque(), wave = tid >> 6, lane = tid & 63, r = lane & 15, q = lane >> 4;
  if (NA) {
    for (int e = tid; e < 15 * 31; e += 256) rpbl[e] = rpb_h[e] * 1.4426950408889634f;
  }
  bf16x8 aq[MT][DQ / 32];
#pragma unroll
  for (int mt = 0; mt < MT; mt++)
#pragma unroll
    for (int ks = 0; ks < DQ / 32; ks++)
      aq[mt][ks] = *(const bf16x8*)(qptr + (size_t)(wave * 16 * MT + mt * 16 + r) * qstride + ks * 32 + q * 8);
  float mrow[MT], lrow[MT];
  f32x4 O[MT][8];
#pragma unroll
  for (int mt = 0; mt < MT; mt++) {
    mrow[mt] = -1e30f; lrow[mt] = 0.f;
#pragma unroll
    for (int nt = 0; nt < 8; nt++) O[mt][nt] = f32x4{0, 0, 0, 0};
  }
  const int n0t = 2 * s0.n, nt2 = 2 * (s0.n + s1.n);
  const float scale2 = scale * 1.4426950408889634f;
  int a_goff[NIW], a_vrow[NIW], a_lds[NIW];
#pragma unroll
  for (int i_ = 0; i_ < NIW; i_++) {
    int wi_ = wave + 4 * i_;
    if (wi_ < NKI) {
      int pos_ = wi_ * 1024 + lane * 16, row_ = pos_ / KSB, off_ = pos_ - row_ * KSB;
      bool ok_ = (row_ < 32) && (off_ < DQ * 2);
      a_goff[i_] = ok_ ? row_ * kstride * 2 + off_ : 0;
      a_vrow[i_] = 0;
      a_lds[i_] = pos_;
    } else if (wi_ < NTOT) {
      int pos_ = (wi_ - NKI) * 1024 + lane * 16, row_ = pos_ / VSB, off_ = pos_ - row_ * VSB;
      bool ok_ = off_ < 64;
      a_goff[i_] = ok_ ? off_ : 0;
      a_vrow[i_] = ok_ ? row_ : 0;
      a_lds[i_] = KREG + pos_;
    } else {
      a_goff[i_] = 0; a_vrow[i_] = 0; a_lds[i_] = 3 * STAGE + lane * 16;
    }
  }
#define ATT_ISSUE(T2, ST)                                                                          \
  {                                                                                                \
    int tc_ = min((T2), nt2 - 1);                                                                  \
    bool f_ = tc_ < n0t;                                                                           \
    int ki_ = f_ ? tc_ : tc_ - n0t;                                                                \
    const char* kp_ = (const char*)((f_ ? s0.k : s1.k) + (size_t)ki_ * 32 * kstride);             \
    const char* vp_ = (const char*)((f_ ? s0.vt : s1.vt) + ki_ * 32);                              \
    const int vtsb_ = (f_ ? s0.vt_stride : s1.vt_stride) * 2;                                      \
    char* sb_ = smem + (ST) * STAGE;                                                               \
    _Pragma("unroll") for (int i_ = 0; i_ < NIW; i_++) {                                           \
      int wi_ = wave + 4 * i_;                                                                     \
      const char* src_; char* dst_;                                                                \
      if (wi_ < NKI) { src_ = kp_ + a_goff[i_]; dst_ = sb_ + a_lds[i_]; }                          \
      else if (wi_ < NTOT) { src_ = vp_ + (a_vrow[i_] * vtsb_ + a_goff[i_]); dst_ = sb_ + a_lds[i_]; } \
      else { src_ = kp_; dst_ = smem + a_lds[i_]; }                                                \
      __builtin_amdgcn_global_load_lds((const unsigned*)src_, (unsigned*)dst_, 16, 0, 0);          \
    }                                                                                              \
  }
  ATT_ISSUE(0, 0)
  ATT_ISSUE(1, 1)
  int st = 0;
  for (int t = 0; t < nt2; t++) {
    asm volatile("s_waitcnt vmcnt(%0)" ::"n"(NIW) : "memory");
    lds_barrier();
    {
      int st2 = st + 2; if (st2 >= 3) st2 -= 3;
      ATT_ISSUE(t + 2, st2)
    }
    const bf16_t* Kst = (const bf16_t*)(smem + st * STAGE);
    const bf16_t* Vst = (const bf16_t*)(smem + st * STAGE + KREG);
    const bool first = t < n0t;
    const int ki = first ? t : t - n0t;
    f32x4 S[MT][2];
#pragma unroll
    for (int mt = 0; mt < MT; mt++)
#pragma unroll
      for (int nt = 0; nt < 2; nt++) S[mt][nt] = f32x4{0, 0, 0, 0};
    __builtin_amdgcn_s_setprio(1);
#pragma unroll
    for (int ks = 0; ks < DQ / 32; ks++) {
      bf16x8 ak[2];
#pragma unroll
      for (int nt = 0; nt < 2; nt++) ak[nt] = ldsfrag(Kst + (nt * 16 + r) * KS + ks * 32 + q * 8);
#pragma unroll
      for (int mt = 0; mt < MT; mt++)
#pragma unroll
        for (int nt = 0; nt < 2; nt++) S[mt][nt] = mfma16(ak[nt], aq[mt][ks], S[mt][nt]);
    }
    __builtin_amdgcn_s_setprio(0);
    bf16x8 bp[MT];
#pragma unroll
    for (int mt = 0; mt < MT; mt++) {
      float mx = -1e30f;
#pragma unroll
      for (int nt = 0; nt < 2; nt++)
#pragma unroll
        for (int e = 0; e < 4; e++) {
          float sv = S[mt][nt][e] * scale2;
          if (NA) {
            if (first) {
              int qcol = wave * 16 + r, kcol = (ki & 1) * 32 + nt * 16 + q * 4 + e;
              int win0 = min(max(qcol - 8, 0), 48);
              bool valid = (kcol >= win0) && (kcol < win0 + 16);
              int dri = row0 + (ki >> 1) - rr + 7, dci = min(max(kcol - qcol + 15, 0), 30);
              sv = valid ? sv + rpbl[dri * 31 + dci] : -1e30f;
            }
          }
          S[mt][nt][e] = sv;
          mx = fmaxf(mx, sv);
        }
      mx = fmaxf(mx, __shfl_xor(mx, 16));
      mx = fmaxf(mx, __shfl_xor(mx, 32));
      float mnew = fmaxf(mrow[mt], mx);
      const bool grew = __any(mnew > mrow[mt]);
      float alpha = __builtin_amdgcn_exp2f(mrow[mt] - mnew);
      mrow[mt] = mnew;
      float rs = 0.f;
#pragma unroll
      for (int nt = 0; nt < 2; nt++)
#pragma unroll
        for (int e = 0; e < 4; e++) {
          float pv = __builtin_amdgcn_exp2f(S[mt][nt][e] - mnew);
          S[mt][nt][e] = pv;
          rs += pv;
        }
      lrow[mt] = lrow[mt] * alpha + rs;
      if (grew) {
#pragma unroll
        for (int nt = 0; nt < 8; nt++)
#pragma unroll
          for (int e = 0; e < 4; e++) O[mt][nt][e] *= alpha;
      }
      u32x4 pk;
      pk[0] = pack2(S[mt][0][0], S[mt][0][1]);
      pk[1] = pack2(S[mt][0][2], S[mt][0][3]);
      pk[2] = pack2(S[mt][1][0], S[mt][1][1]);
      pk[3] = pack2(S[mt][1][2], S[mt][1][3]);
      bp[mt] = __builtin_bit_cast(bf16x8, pk);
    }
    __builtin_amdgcn_s_setprio(1);
#pragma unroll
    for (int nt = 0; nt < 8; nt++) {
      const bf16_t* vrow = Vst + (nt * 16 + r) * VS + q * 4;
      u32x2 lo = *(const u32x2*)vrow;
      u32x2 hi = *(const u32x2*)(vrow + 16);
      u32x4 vv; vv[0] = lo[0]; vv[1] = lo[1]; vv[2] = hi[0]; vv[3] = hi[1];
      bf16x8 av = __builtin_bit_cast(bf16x8, vv);
#pragma unroll
      for (int mt = 0; mt < MT; mt++) O[mt][nt] = mfma16(av, bp[mt], O[mt][nt]);
    }
    __builtin_amdgcn_s_setprio(0);
    st = (st == 2) ? 0 : st + 1;
  }
#undef ATT_ISSUE
  asm volatile("s_waitcnt vmcnt(0)" ::: "memory");
#pragma unroll
  for (int mt = 0; mt < MT; mt++) {
    float l = lrow[mt];
    l += __shfl_xor(l, 16);
    l += __shfl_xor(l, 32);
    float inv = 1.f / l;
    int row = wave * 16 * MT + mt * 16 + r;
    u32x2 zz[8];
#pragma unroll
    for (int nt = 0; nt < 8; nt++) zz[nt] = *(const u32x2*)(zptr + (size_t)row * DIN + nt * 16 + q * 4);
#pragma unroll
    for (int nt = 0; nt < 8; nt++) {
      int d = nt * 16 + q * 4;
      f32x4 o;
      o[0] = O[mt][nt][0] * inv * siluf(lo2f(zz[nt][0]));
      o[1] = O[mt][nt][1] * inv * siluf(hi2f(zz[nt][0]));
      o[2] = O[mt][nt][2] * inv * siluf(lo2f(zz[nt][1]));
      o[3] = O[mt][nt][3] * inv * siluf(hi2f(zz[nt][1]));
      u32x2 pk = pack4(o);
      if (!enabled) pk = u32x2{0u, 0u};
      *(u32x2*)(optr + (size_t)row * DM + d) = pk;
    }
  }
  __syncthreads();
}

__device__ __forceinline__ void gdn_chain(const Params& p, int item, char* smem) {
  bf16_t* Wl = (bf16_t*)smem;
  bf16_t* Qd = Wl + 64 * 136;
  bf16_t* KdT = Qd + 64 * 136;
  bf16_t* QKl = KdT + 128 * 72;
  bf16_t* St = QKl + 64 * 72;
  bf16_t* VNt = St + 32 * 136;
  const int tid = tid_opaque(), wave = tid >> 6, lane = tid & 63, r = lane & 15, q = lane >> 4;
  const int s = item & 3, dir = (item >> 2) & 1, h = (item >> 3) & 3, b = item >> 5;
  const bf16_t* GQ = (const bf16_t*)(wsb(p) + OFF_GQ);
  const bf16_t* GK = (const bf16_t*)(wsb(p) + OFF_GK);
  const float* GAM = (const float*)(wsb(p) + OFF_GAM);
  bf16_t* GO = (bf16_t*)(wsb(p) + OFF_GO) + (size_t)dir * NTOK * 512;
  const int ic0 = ((b * 4 + h) * 2 + dir) * NCHUNK;
  const bf16_t* WNb = (const bf16_t*)(wsb(p) + OFF_WNEG) + (size_t)ic0 * 8192;
  const bf16_t* Ub = (const bf16_t*)(wsb(p) + OFF_U) + (size_t)ic0 * 8192;
  const bf16_t* QKb = (const bf16_t*)(wsb(p) + OFF_QK) + (size_t)ic0 * 4096;
  const float* GAMb = GAM + (size_t)ic0 * 64;
  f32x4 Sacc[2][2];
#pragma unroll
  for (int mt = 0; mt < 2; mt++)
#pragma unroll
    for (int nt = 0; nt < 2; nt++) Sacc[mt][nt] = f32x4{0, 0, 0, 0};
  u32x4 pW[4], pQ[4], pK[4], pQK[2];
  bf16_t pU[8];
  float pgq[4], pgk, pgl;
#define GDN_PREFETCH(cc)                                                                          \
  {                                                                                               \
    const bf16_t* Wn = WNb + (size_t)(cc) * 8192;                                                 \
    const bf16_t* Ug = Ub + (size_t)(cc) * 8192;                                                  \
    const bf16_t* QKg = QKb + (size_t)(cc) * 4096;                                                \
    const float* gam = GAMb + (size_t)(cc) * 64;                                                  \
    _Pragma("unroll") for (int i = 0; i < 4; i++) {                                               \
      int ch = tid + 256 * i, row = ch >> 4, c8 = (ch & 15) * 8;                                  \
      pW[i] = *(const u32x4*)(Wn + row * 128 + c8);                                               \
      int tok = chain_tok(b, dir, (cc), row);                                                     \
      pQ[i] = *(const u32x4*)(GQ + (size_t)tok * 512 + h * 128 + c8);                             \
      pgq[i] = gam[row];                                                                          \
    }                                                                                             \
    {                                                                                             \
      int tokl = chain_tok(b, dir, (cc), lane);                                                   \
      const bf16_t* src = GK + (size_t)tokl * 512 + h * 128 + wave * 32;                          \
      _Pragma("unroll") for (int i = 0; i < 4; i++) pK[i] = *(const u32x4*)(src + i * 8);         \
      pgk = gam[lane]; pgl = gam[63];                                                             \
    }                                                                                             \
    _Pragma("unroll") for (int i = 0; i < 2; i++) {                                               \
      int ch = tid + 256 * i, row = ch >> 3, c8 = (ch & 7) * 8;                                   \
      pQK[i] = *(const u32x4*)(QKg + row * 64 + c8);                                              \
    }                                                                                             \
    _Pragma("unroll") for (int nt = 0; nt < 2; nt++)                                              \
      _Pragma("unroll") for (int e = 0; e < 4; e++)                                               \
        pU[nt * 4 + e] = Ug[(wave * 16 + q * 4 + e) * 128 + s * 32 + nt * 16 + r];                \
  }
  f32x4 aprev[2] = {f32x4{0, 0, 0, 0}, f32x4{0, 0, 0, 0}};
  GDN_PREFETCH(0)
  for (int c = 0; c < NCHUNK; c++) {
#pragma unroll
    for (int i = 0; i < 4; i++) {
      int ch = tid + 256 * i, row = ch >> 4, c8 = (ch & 15) * 8;
      *(u32x4*)(Wl + row * 136 + c8) = pW[i];
      float eg = __expf(pgq[i]);
      u32x4 v = pQ[i], o;
      o.x = pack2(lo2f(v.x) * eg, hi2f(v.x) * eg); o.y = pack2(lo2f(v.y) * eg, hi2f(v.y) * eg);
      o.z = pack2(lo2f(v.z) * eg, hi2f(v.z) * eg); o.w = pack2(lo2f(v.w) * eg, hi2f(v.w) * eg);
      *(u32x4*)(Qd + row * 136 + c8) = o;
    }
    {
      float ek = __expf(pgl - pgk);
#pragma unroll
      for (int i = 0; i < 4; i++) {
        u32x4 v = pK[i];
        int d0 = wave * 32 + i * 8;
#pragma unroll
        for (int e = 0; e < 4; e++) {
          unsigned pk = pack2(lo2f(v[e]) * ek, hi2f(v[e]) * ek);
          KdT[(d0 + 2 * e) * 72 + lane] = (bf16_t)pk;
          KdT[(d0 + 2 * e + 1) * 72 + lane] = (bf16_t)(pk >> 16);
        }
      }
    }
#pragma unroll
    for (int i = 0; i < 2; i++) {
      int ch = tid + 256 * i, row = ch >> 3, c8 = (ch & 7) * 8;
      *(u32x4*)(QKl + row * 72 + c8) = pQK[i];
    }
#pragma unroll
    for (int mt = 0; mt < 2; mt++)
#pragma unroll
      for (int nt = 0; nt < 2; nt++)
        *(u32x2*)(St + (nt * 16 + r) * 136 + (2 * wave + mt) * 16 + q * 4) = pack4(Sacc[mt][nt]);
    f32x4 av[2], ao[2];
#pragma unroll
    for (int nt = 0; nt < 2; nt++) {
#pragma unroll
      for (int e = 0; e < 4; e++) av[nt][e] = bf2f(pU[nt * 4 + e]);
      ao[nt] = f32x4{0, 0, 0, 0};
    }
    const float egl = __expf(pgl);
    lds_barrier();
    if (c > 0) {
#pragma unroll
      for (int e = 0; e < 4; e++) {
        int tok = chain_tok(b, dir, c - 1, wave * 16 + q * 4 + e);
#pragma unroll
        for (int nt = 0; nt < 2; nt++) GO[(size_t)tok * 512 + h * 128 + s * 32 + nt * 16 + r] = f2bf(aprev[nt][e]);
      }
    }
    if (c + 1 < NCHUNK) GDN_PREFETCH(c + 1)
#pragma unroll
    for (int ks = 0; ks < 4; ks++) {
      bf16x8 aW = ldsfrag(Wl + (wave * 16 + r) * 136 + ks * 32 + q * 8);
      bf16x8 aQ = ldsfrag(Qd + (wave * 16 + r) * 136 + ks * 32 + q * 8);
#pragma unroll
      for (int nt = 0; nt < 2; nt++) {
        bf16x8 bS = ldsfrag(St + (nt * 16 + r) * 136 + ks * 32 + q * 8);
        av[nt] = mfma16(aW, bS, av[nt]);
        ao[nt] = mfma16(aQ, bS, ao[nt]);
      }
    }
#pragma unroll
    for (int nt = 0; nt < 2; nt++) *(u32x2*)(VNt + (nt * 16 + r) * 72 + wave * 16 + q * 4) = pack4(av[nt]);
    lds_barrier();
#pragma unroll
    for (int mt = 0; mt < 2; mt++)
#pragma unroll
      for (int nt = 0; nt < 2; nt++)
#pragma unroll
        for (int e = 0; e < 4; e++) Sacc[mt][nt][e] *= egl;
#pragma unroll
    for (int kk = 0; kk < 2; kk++) {
      bf16x8 aQK = ldsfrag(QKl + (wave * 16 + r) * 72 + kk * 32 + q * 8);
      bf16x8 bV[2];
#pragma unroll
      for (int nt = 0; nt < 2; nt++) bV[nt] = ldsfrag(VNt + (nt * 16 + r) * 72 + kk * 32 + q * 8);
#pragma unroll
      for (int nt = 0; nt < 2; nt++) ao[nt] = mfma16(aQK, bV[nt], ao[nt]);
#pragma unroll
      for (int mt = 0; mt < 2; mt++) {
        bf16x8 aK = ldsfrag(KdT + ((2 * wave + mt) * 16 + r) * 72 + kk * 32 + q * 8);
#pragma unroll
        for (int nt = 0; nt < 2; nt++) Sacc[mt][nt] = mfma16(aK, bV[nt], Sacc[mt][nt]);
      }
    }
    aprev[0] = ao[0]; aprev[1] = ao[1];
    lds_barrier();
  }
#pragma unroll
  for (int e = 0; e < 4; e++) {
    int tok = chain_tok(b, dir, NCHUNK - 1, wave * 16 + q * 4 + e);
#pragma unroll
    for (int nt = 0; nt < 2; nt++) GO[(size_t)tok * 512 + h * 128 + s * 32 + nt * 16 + r] = f2bf(aprev[nt][e]);
  }
#undef GDN_PREFETCH
}

__device__ __forceinline__ void ssd_chain(const Params& p, int l, int item, char* smem) {
  bf16_t* Cl = (bf16_t*)smem;
  bf16_t* Bl = Cl + 64 * 136;
  bf16_t* BdT = Bl + 64 * 136;
  bf16_t* XdtT = BdT + 128 * 72;
  bf16_t* Hl = XdtT + 32 * 72;
  bf16_t* Scl = Hl + 32 * 136;
  float* cuml = (float*)(Scl + 64 * 72);
  const int tid = tid_opaque(), wave = tid >> 6, lane = tid & 63, r = lane & 15, q = lane >> 4;
  const int ph = item & 1, dir = (item >> 1) & 1, hh = (item >> 2) & 7, b = item >> 5;
  const int grp = hh >> 2;
  const bf16_t* SX = (const bf16_t*)(wsb(p) + OFF_SX);
  const bf16_t* SB = (const bf16_t*)(wsb(p) + OFF_SB);
  const bf16_t* SC = (const bf16_t*)(wsb(p) + OFF_SC);
  const float* SDT = (const float*)(wsb(p) + OFF_SDT);
  bf16_t* SY = (bf16_t*)(wsb(p) + OFF_SY) + (size_t)dir * NTOK * 512;
  const float Ah = -__expf(inp(p, 23)[l * 16 + dir * 8 + hh]);
  f32x4 Hacc[2][2];
#pragma unroll
  for (int mt = 0; mt < 2; mt++)
#pragma unroll
    for (int nt = 0; nt < 2; nt++) Hacc[mt][nt] = f32x4{0, 0, 0, 0};
  u32x4 pC[4], pB[4], pBt[4], pX;
  float pdt;
#define SSD_PREFETCH(cc)                                                                          \
  {                                                                                               \
    _Pragma("unroll") for (int i = 0; i < 4; i++) {                                               \
      int ch = tid + 256 * i, row = ch >> 4, c8 = (ch & 15) * 8;                                  \
      int tok = chain_tok(b, dir, (cc), row);                                                     \
      pC[i] = *(const u32x4*)(SC + (size_t)tok * 256 + grp * 128 + c8);                           \
      pB[i] = *(const u32x4*)(SB + (size_t)tok * 256 + grp * 128 + c8);                           \
    }                                                                                             \
    int tokl = chain_tok(b, dir, (cc), lane);                                                     \
    const bf16_t* src = SB + (size_t)tokl * 256 + grp * 128 + wave * 32;                          \
    _Pragma("unroll") for (int i = 0; i < 4; i++) pBt[i] = *(const u32x4*)(src + i * 8);          \
    pX = *(const u32x4*)(SX + (size_t)tokl * 512 + hh * 64 + ph * 32 + wave * 8);                 \
    pdt = SDT[(size_t)tokl * 16 + dir * 8 + hh];                                                  \
  }
  f32x4 yprev[2] = {f32x4{0, 0, 0, 0}, f32x4{0, 0, 0, 0}};
  SSD_PREFETCH(0)
  for (int c = 0; c < NCHUNK; c++) {
    const float dtl = pdt;
    const float cum = wave_incl_scan(dtl * Ah, lane);
    const float cum_last = lane_bcast(cum, 63);
    if (wave == 0) cuml[lane] = cum;
#pragma unroll
    for (int i = 0; i < 4; i++) {
      int ch = tid + 256 * i, row = ch >> 4, c8 = (ch & 15) * 8;
      *(u32x4*)(Cl + row * 136 + c8) = pC[i];
      *(u32x4*)(Bl + row * 136 + c8) = pB[i];
    }
    {
      float ek = __expf(cum_last - cum);
#pragma unroll
      for (int i = 0; i < 4; i++) {
        u32x4 v = pBt[i];
        int d0 = wave * 32 + i * 8;
#pragma unroll
        for (int e = 0; e < 4; e++) {
          unsigned pk = pack2(lo2f(v[e]) * ek, hi2f(v[e]) * ek);
          BdT[(d0 + 2 * e) * 72 + lane] = (bf16_t)pk;
          BdT[(d0 + 2 * e + 1) * 72 + lane] = (bf16_t)(pk >> 16);
        }
      }
      u32x4 v = pX;
      int p0 = wave * 8;
#pragma unroll
      for (int e = 0; e < 4; e++) {
        unsigned pk = pack2(lo2f(v[e]) * dtl, hi2f(v[e]) * dtl);
        XdtT[(p0 + 2 * e) * 72 + lane] = (bf16_t)pk;
        XdtT[(p0 + 2 * e + 1) * 72 + lane] = (bf16_t)(pk >> 16);
      }
    }
#pragma unroll
    for (int mt = 0; mt < 2; mt++)
#pragma unroll
      for (int nt = 0; nt < 2; nt++)
        *(u32x2*)(Hl + (nt * 16 + r) * 136 + (2 * wave + mt) * 16 + q * 4) = pack4(Hacc[mt][nt]);
    lds_barrier();
    if (c > 0) {
#pragma unroll
      for (int e = 0; e < 4; e++) {
        int tok = chain_tok(b, dir, c - 1, wave * 16 + q * 4 + e);
#pragma unroll
        for (int nt = 0; nt < 2; nt++) SY[(size_t)tok * 512 + hh * 64 + ph * 32 + nt * 16 + r] = f2bf(yprev[nt][e]);
      }
    }
    if (c + 1 < NCHUNK) SSD_PREFETCH(c + 1)
    f32x4 as[4], ay[2];
#pragma unroll
    for (int nt = 0; nt < 4; nt++) as[nt] = f32x4{0, 0, 0, 0};
#pragma unroll
    for (int nt = 0; nt < 2; nt++) ay[nt] = f32x4{0, 0, 0, 0};
#pragma unroll
    for (int ks = 0; ks < 4; ks++) {
      bf16x8 aC = ldsfrag(Cl + (wave * 16 + r) * 136 + ks * 32 + q * 8);
#pragma unroll
      for (int nt = 0; nt < 4; nt++) as[nt] = mfma16(aC, ldsfrag(Bl + (nt * 16 + r) * 136 + ks * 32 + q * 8), as[nt]);
#pragma unroll
      for (int nt = 0; nt < 2; nt++) ay[nt] = mfma16(aC, ldsfrag(Hl + (nt * 16 + r) * 136 + ks * 32 + q * 8), ay[nt]);
    }
#pragma unroll
    for (int e = 0; e < 4; e++) {
      int i = wave * 16 + q * 4 + e;
      float ci = cuml[i];
      float ei = __expf(ci);
#pragma unroll
      for (int nt = 0; nt < 2; nt++) ay[nt][e] *= ei;
#pragma unroll
      for (int nt = 0; nt < 4; nt++) {
        int j = nt * 16 + r;
        float v = (j <= i) ? as[nt][e] * __expf(ci - cuml[j]) : 0.f;
        Scl[i * 72 + j] = f2bf(v);
      }
    }
    lds_barrier();
    const float ecl = __expf(cum_last);
#pragma unroll
    for (int mt = 0; mt < 2; mt++)
#pragma unroll
      for (int nt = 0; nt < 2; nt++)
#pragma unroll
        for (int e = 0; e < 4; e++) Hacc[mt][nt][e] *= ecl;
#pragma unroll
    for (int kk = 0; kk < 2; kk++) {
      bf16x8 aS = ldsfrag(Scl + (wave * 16 + r) * 72 + kk * 32 + q * 8);
      bf16x8 bX[2];
#pragma unroll
      for (int nt = 0; nt < 2; nt++) bX[nt] = ldsfrag(XdtT + (nt * 16 + r) * 72 + kk * 32 + q * 8);
#pragma unroll
      for (int nt = 0; nt < 2; nt++) ay[nt] = mfma16(aS, bX[nt], ay[nt]);
#pragma unroll
      for (int mt = 0; mt < 2; mt++) {
        bf16x8 aB = ldsfrag(BdT + ((2 * wave + mt) * 16 + r) * 72 + kk * 32 + q * 8);
#pragma unroll
        for (int nt = 0; nt < 2; nt++) Hacc[mt][nt] = mfma16(aB, bX[nt], Hacc[mt][nt]);
      }
    }
    yprev[0] = ay[0]; yprev[1] = ay[1];
    lds_barrier();
  }
#pragma unroll
  for (int e = 0; e < 4; e++) {
    int tok = chain_tok(b, dir, NCHUNK - 1, wave * 16 + q * 4 + e);
#pragma unroll
    for (int nt = 0; nt < 2; nt++) SY[(size_t)tok * 512 + hh * 64 + ph * 32 + nt * 16 + r] = f2bf(yprev[nt][e]);
  }
#undef SSD_PREFETCH
}

__device__ __forceinline__ void phase_mix(const Params& p, int l, char* smem, int rep = 0) {
  constexpr int N_GC = 128, N_SC = 128, N_ML = NB * 4 * 32, N_MC = NB * 4 * 2, N_NL = NB * 64 * 4, N_NC = NB * 4 * 2;
  constexpr int NT = N_GC + N_SC + N_ML + N_MC + N_NL + N_NC;
  const bf16_t* PROJ = (const bf16_t*)(wsb(p) + OFF_PROJ);
  bf16_t* MIX = (bf16_t*)(wsb(p) + OFF_H);
  const bf16_t* MQ = (const bf16_t*)(wsb(p) + OFF_MQ);
  const bf16_t* MK = (const bf16_t*)(wsb(p) + OFF_MK);
  const bf16_t* MVTL = (const bf16_t*)(wsb(p) + OFF_MVTL);
  const bf16_t* MVTC = (const bf16_t*)(wsb(p) + OFF_MVTC);
  const bf16_t* NQ = (const bf16_t*)(wsb(p) + OFF_NQ);
  const bf16_t* NK = (const bf16_t*)(wsb(p) + OFF_NK);
  const bf16_t* NVTL = (const bf16_t*)(wsb(p) + OFF_NVTL);
  const bf16_t* NVTC = (const bf16_t*)(wsb(p) + OFF_NVTC);
  const float mscale = 0.07216878364870322f;
  const float nscale = 0.08838834764831845f;
  (void)NT;
  const int xcd = bid_opaque() & 7;
  int* ctr = (int*)(wsb(p) + OFF_WQ) + 32 + (l * 8 + xcd) + rep * 128;
  const int lbr = bid_opaque() >> 3;
  const int lbx = ((lbr & 1) == 0 && ((int)gridDim.x >> 3) >= 64) ? (lbr >> 1) : (((int)gridDim.x >> 3) >= 64 ? 1000 : lbr);
  if (lbx < 16) gdn_chain(p, xcd * 16 + lbx, smem);
  else if (lbx < 32) ssd_chain(p, l, xcd * 16 + (lbx - 16), smem);
  if (((int)gridDim.x >> 3) < 32) {
    for (int c = lbx + ((int)gridDim.x >> 3); c < 32; c += ((int)gridDim.x >> 3)) {
      if (c < 16) gdn_chain(p, xcd * 16 + c, smem); else ssd_chain(p, l, xcd * 16 + (c - 16), smem);
    }
  }
  int it = 32 + wq_next(ctr, smem);
  while (it < 100) {
    int tok0, h, b; KSeg s0, s1;
    if (it < 96) {
      int i = it - 32, bh = xcd * 2 + (i >> 5), qb = i & 31; b = bh >> 2; h = bh & 3;
      tok0 = b * TL + qb * 128;
      s1 = KSeg{MK + (size_t)(b * TL) * 768 + h * 192, MVTL + (size_t)((b * 4 + h) * 128) * TL, TL, 64};
    } else {
      int i = it - 96, bh = xcd * 2 + (i >> 1), qb = i & 1; b = bh >> 2; h = bh & 3;
      tok0 = NTOK_L + b * TC + qb * 128;
      s1 = KSeg{MK, MVTL, TL, 0};
    }
    s0 = KSeg{MK + (size_t)(NTOK_L + b * TC) * 768 + h * 192, MVTC + (size_t)((b * 4 + h) * 128) * TC, TC, 4};
    attn_item<192, 2, false>(smem, MQ + (size_t)tok0 * 768 + h * 192, 768, s0, s1, 768, mscale, nullptr, 0, 0,
                             PROJ + (size_t)tok0 * DIN + C_MZ + h * 128, MIX + (size_t)tok0 * DM + 1024 + h * 128, EN_MLA);
    it = 32 + wq_next(ctr, smem);
  }
  while (it < 228) {
    int i = it - 100, bh = xcd * 2 + (i >> 6), rr = i & 63, b = bh >> 2, h = bh & 3;
    int tok0 = b * TL + rr * 64;
    int row0 = min(max(rr - 4, 0), 56);
    KSeg s0{NK + (size_t)(b * TL + row0 * 64) * 512 + h * 128, NVTL + (size_t)((b * 4 + h) * 128) * TL + row0 * 64, TL, 8};
    KSeg s1{NK + (size_t)(NTOK_L + b * TC) * 512 + h * 128, NVTC + (size_t)((b * 4 + h) * 128) * TC, TC, 4};
    attn_item<128, 1, true>(smem, NQ + (size_t)tok0 * 512 + h * 128, 512, s0, s1, 512, nscale,
                            inp(p, 14) + (size_t)(l * 4 + h) * 15 * 31, rr, row0,
                            PROJ + (size_t)tok0 * DIN + C_NZ + h * 128, MIX + (size_t)tok0 * DM + 512 + h * 128, EN_NA);
    it = 32 + wq_next(ctr, smem);
  }
  while (it < 232) {
    int i = it - 228, bh = xcd * 2 + (i >> 1), qb = i & 1, b = bh >> 2, h = bh & 3;
    int tok0 = NTOK_L + b * TC + qb * 128;
    KSeg s0{NK + (size_t)(NTOK_L + b * TC) * 512 + h * 128, NVTC + (size_t)((b * 4 + h) * 128) * TC, TC, 4};
    KSeg s1{NK, NVTC, TC, 0};
    attn_item<128, 2, false>(smem, NQ + (size_t)tok0 * 512 + h * 128, 512, s0, s1, 512, nscale, nullptr, 0, 0,
                             PROJ + (size_t)tok0 * DIN + C_NZ + h * 128, MIX + (size_t)tok0 * DM + 512 + h * 128, EN_NA);
    it = 32 + wq_next(ctr, smem);
  }
}

__device__ __forceinline__ void phase_post(const Params& p, int l) {
  const int wave = tid_opaque() >> 6, lane = tid_opaque() & 63;
  const bf16_t* PROJ = (const bf16_t*)(wsb(p) + OFF_PROJ);
  bf16_t* MIX = (bf16_t*)(wsb(p) + OFF_H);
  const bf16_t* GO = (const bf16_t*)(wsb(p) + OFF_GO);
  const bf16_t* SY = (const bf16_t*)(wsb(p) + OFF_SY);
  const bf16_t* SX = (const bf16_t*)(wsb(p) + OFF_SX);
  const int nit = NTOK / 4, gstep = gridDim.x;
  const float2 gw = *(const float2*)(inp(p, 11) + l * 128 + lane * 2);
  float2 sw[4]; float sd[4];
#pragma unroll
  for (int i = 0; i < 4; i++) {
    sw[i] = *(const float2*)(inp(p, 26) + l * 512 + lane * 2 + 128 * i);
    sd[i] = inp(p, 25)[l * 8 + (lane >> 5) + 2 * i];
  }
  unsigned cu[28], nu[28];
#define POST_LOAD(TOK, U)                                                                         \
  {                                                                                               \
    const bf16_t* P0 = PROJ + (size_t)(TOK) * DIN;                                                \
    _Pragma("unroll") for (int h = 0; h < 4; h++) {                                               \
      int c = h * 128 + lane * 2;                                                                 \
      U[h] = *(const unsigned*)(GO + (size_t)(TOK) * 512 + c);                                    \
      U[4 + h] = *(const unsigned*)(GO + (size_t)NTOK * 512 + (size_t)(TOK) * 512 + c);           \
      U[8 + h] = *(const unsigned*)(P0 + C_GZ + c);                                               \
    }                                                                                             \
    _Pragma("unroll") for (int i = 0; i < 4; i++) {                                               \
      int c = lane * 2 + 128 * i;                                                                 \
      U[12 + i] = *(const unsigned*)(SY + (size_t)(TOK) * 512 + c);                               \
      U[16 + i] = *(const unsigned*)(SY + (size_t)NTOK * 512 + (size_t)(TOK) * 512 + c);          \
      U[20 + i] = *(const unsigned*)(SX + (size_t)(TOK) * 512 + c);                               \
      U[24 + i] = *(const unsigned*)(P0 + C_SZ + c);                                              \
    }                                                                                             \
  }
  int it = bid_opaque();
  if (it < nit) POST_LOAD(it * 4 + wave, cu)
  for (; it < nit; it += gstep) {
    const int tok = it * 4 + wave;
    const bool more = it + gstep < nit;
    if (more) POST_LOAD((it + gstep) * 4 + wave, nu)
#pragma unroll
    for (int h = 0; h < 4; h++) {
      int c = h * 128 + lane * 2;
      float oa = lo2f(cu[h]) + lo2f(cu[4 + h]), ob = hi2f(cu[h]) + hi2f(cu[4 + h]);
      float ss = wave_sum(oa * oa + ob * ob);
      float rn = rsqrtf(ss * (1.f / 128.f) + EPS);
      float ra = oa * rn * gw.x * siluf(lo2f(cu[8 + h]));
      float rb = ob * rn * gw.y * siluf(hi2f(cu[8 + h]));
      *(unsigned*)(MIX + (size_t)tok * DM + c) = EN_GDN ? pack2(ra, rb) : 0u;
    }
    {
      float ya[4], yb[4], ss = 0.f;
#pragma unroll
      for (int i = 0; i < 4; i++) {
        ya[i] = (lo2f(cu[12 + i]) + lo2f(cu[16 + i]) + sd[i] * lo2f(cu[20 + i])) * siluf(lo2f(cu[24 + i]));
        yb[i] = (hi2f(cu[12 + i]) + hi2f(cu[16 + i]) + sd[i] * hi2f(cu[20 + i])) * siluf(hi2f(cu[24 + i]));
        ss += ya[i] * ya[i] + yb[i] * yb[i];
      }
      ss = wave_sum(ss);
      float rn = rsqrtf(ss * (1.f / 512.f) + EPS);
#pragma unroll
      for (int i = 0; i < 4; i++) {
        int c = lane * 2 + 128 * i;
        *(unsigned*)(MIX + (size_t)tok * DM + 1536 + c) = EN_SSD ? pack2(ya[i] * rn * sw[i].x, yb[i] * rn * sw[i].y) : 0u;
      }
    }
    if (more) {
#pragma unroll
      for (int i = 0; i < 28; i++) cu[i] = nu[i];
    }
  }
#undef POST_LOAD
}

__device__ __forceinline__ void phase_outproj(const Params& p, int l, char* smem) {
  const bf16_t* MIX = (const bf16_t*)(wsb(p) + OFF_H);
  const bf16_t* W = (const bf16_t*)(wsb(p) + OFF_WOUT) + (size_t)l * DM * DM;
  const int MTn = (l == NL - 1) ? NTOK_L / 128 : NTOK / 128;
  const int xcd = bid_opaque() & 7, lb = bid_opaque() >> 3, nlb = (int)gridDim.x >> 3;
  const int mper = MTn >> 3;
  const int ntot = mper * 8, nbig = (ntot / nlb) * nlb;
  for (int j = lb; j < nbig; j += nlb) {
    int mi = j >> 3, nt = j & 7;
    int mt = xcd + 8 * mi;
    int m0 = mt * 128, n0 = nt * 256;
    int isc, b, t0; tok_decode(m0, isc, b, t0);
    const float* gate = (const float*)(wsb(p) + OFF_MOD) + (size_t)(l * 5 + (isc ? 4 : b)) * 6144 + 4096;
    f32x4 acc[4][8];
    gemm128x256(MIX + (size_t)m0 * DM, DM, W + (size_t)n0 * DM, DM, DM, smem, acc);
    {
      float* Cf = (float*)smem;
      const int tid = tid_opaque(), wave = tid >> 6, lane = tid & 63, r = lane & 15, q = lane >> 4;
      const int wr = wave >> 1, wc = wave & 1;
      const int c4 = (tid & 31) * 4;
#pragma unroll
      for (int hf = 0; hf < 2; hf++) {
        if (wc == hf) {
#pragma unroll
          for (int i = 0; i < 4; i++)
#pragma unroll
            for (int j2 = 0; j2 < 8; j2++)
              *(f32x4*)(Cf + (wr * 64 + i * 16 + r) * 132 + j2 * 16 + q * 4) = acc[i][j2];
        }
        lds_barrier();
        const int gc = n0 + hf * 128 + c4;
        const f32x4 g = *(const f32x4*)(gate + gc);
#pragma unroll
        for (int c0 = 0; c0 < 16; c0 += 8) {
          f32x4 xv[8];
#pragma unroll
          for (int c = 0; c < 8; c++) {
            int row = (tid >> 5) + 8 * (c0 + c);
            xv[c] = *(const f32x4*)(xrow_src(p, l, m0 + row) + gc);
          }
#pragma unroll
          for (int c = 0; c < 8; c++) {
            int row = (tid >> 5) + 8 * (c0 + c);
            f32x4 y = *(const f32x4*)(Cf + row * 132 + c4);
            *(f32x4*)(xrow_dst(p, m0 + row) + gc) = xv[c] + g * y;
          }
        }
        __syncthreads();
      }
    }
  }
  for (int sidx = lb; sidx < (ntot - nbig) * 2; sidx += nlb) {
    int j = nbig + (sidx >> 1), hf2 = sidx & 1;
    int mi = j >> 3, nt = j & 7;
    int mt = xcd + 8 * mi;
    int m0 = mt * 128, n0 = nt * 256 + hf2 * 128;
    int isc, b, t0; tok_decode(m0, isc, b, t0);
    const float* gate = (const float*)(wsb(p) + OFF_MOD) + (size_t)(l * 5 + (isc ? 4 : b)) * 6144 + 4096;
    f32x4 acc[4][4];
    gemm128(MIX + (size_t)m0 * DM, DM, W + (size_t)n0 * DM, DM, DM, smem, acc);
    {
      float* Cf = (float*)smem;
      const int tid = tid_opaque(), wave = tid >> 6, lane = tid & 63, r = lane & 15, q = lane >> 4;
      const int wr = wave >> 1, wc = wave & 1;
#pragma unroll
      for (int i = 0; i < 4; i++)
#pragma unroll
        for (int j2 = 0; j2 < 4; j2++)
          *(f32x4*)(Cf + (wr * 64 + i * 16 + r) * 132 + wc * 64 + j2 * 16 + q * 4) = acc[i][j2];
      lds_barrier();
      const int c4 = (tid & 31) * 4;
      const f32x4 g = *(const f32x4*)(gate + n0 + c4);
#pragma unroll
      for (int c0 = 0; c0 < 16; c0 += 8) {
        f32x4 xv[8];
#pragma unroll
        for (int c = 0; c < 8; c++) {
          int row = (tid >> 5) + 8 * (c0 + c);
          xv[c] = *(const f32x4*)(xrow_src(p, l, m0 + row) + n0 + c4);
        }
#pragma unroll
        for (int c = 0; c < 8; c++) {
          int row = (tid >> 5) + 8 * (c0 + c);
          f32x4 y = *(const f32x4*)(Cf + row * 132 + c4);
          *(f32x4*)(xrow_dst(p, m0 + row) + n0 + c4) = xv[c] + g * y;
        }
      }
    }
    __syncthreads();
  }
}

#define XB_TMO      128
#define XB_XCNT(j)  (256  + 64 * (j))
#define XB_XSUB(j)  (1280 + 64 * (j))
#define XB_XGEN(j)  (2304 + 64 * (j))
#define XB_TOP      3328
#define XB_TOPGEN   3392
#define XCD_BAR_WORDS 3456
#define XB_SPIN_CAP (1u << 20)
#define LAS __attribute__((address_space(3)))
__device__ __forceinline__ unsigned xb_ld(unsigned* p)              { return __hip_atomic_load(p, __ATOMIC_RELAXED, __HIP_MEMORY_SCOPE_AGENT); }
__device__ __forceinline__ unsigned xb_add(unsigned* p, unsigned v) { return __hip_atomic_fetch_add(p, v, __ATOMIC_RELAXED, __HIP_MEMORY_SCOPE_AGENT); }
__device__ __forceinline__ unsigned xb_xcc_id() { return (unsigned)__builtin_amdgcn_s_getreg((3 << 11) | 20) & 0xFu; }
#define XB_SPIN(cond, bar) do { unsigned _sp = 0; while (cond) { __builtin_amdgcn_s_sleep(1); \
    if ((++_sp & 255u) == 0u) { if (xb_ld(&(bar)[XB_TMO])) break; if (_sp > XB_SPIN_CAP) { atomicAdd(&(bar)[XB_TMO], 1u); break; } } } } while (0)
struct XcdBarrier { unsigned* bar; unsigned x; volatile LAS unsigned* st; };
__device__ __forceinline__ XcdBarrier xcd_barrier_post(unsigned* bar, volatile LAS unsigned* st) {
  XcdBarrier b; b.bar = bar; b.x = xb_xcc_id(); b.st = st;
  if (threadIdx.x == 0) (void)xb_add(&bar[XB_XCNT(b.x)], 1u);
  return b;
}
__device__ __forceinline__ void xcd_barrier_complete(unsigned* bar, unsigned x, unsigned& nloc, unsigned& nx) {
  const unsigned G = gridDim.x * gridDim.y * gridDim.z;
  unsigned sum, cnt, mine, sp = 0u;
  for (;;) {
    sum = 0u; cnt = 0u; mine = 0u;
#pragma unroll
    for (unsigned j = 0; j < 16; ++j) { const unsigned c = xb_ld(&bar[XB_XCNT(j)]); sum += c; cnt += (c > 0u) ? 1u : 0u; mine = (j == x) ? c : mine; }
    if (sum == G) break;
    __builtin_amdgcn_s_sleep(1);
    if ((++sp & 255u) == 0u) { if (xb_ld(&bar[XB_TMO])) break; if (sp > XB_SPIN_CAP) { atomicAdd(&bar[XB_TMO], 1u); break; } }
  }
  nloc = mine > 0u ? mine : 1u; nx = cnt > 0u ? cnt : 1u;
}
__device__ __forceinline__ void xcd_barrier(const XcdBarrier& b) {
  asm volatile("s_waitcnt vmcnt(0)" ::: "memory");
  __syncthreads();
  if (threadIdx.x == 0) {
    unsigned* bar = b.bar;
    __builtin_amdgcn_s_waitcnt(0);
    unsigned nloc = b.st[0], nx = b.st[1];
    if (nloc == 0u) { xcd_barrier_complete(bar, b.x, nloc, nx); b.st[0] = nloc; b.st[1] = nx; }
    const unsigned old = xb_add(&bar[XB_XSUB(b.x)], 1u);
    const unsigned gen = old / nloc;
    if (old + 1u == (gen + 1u) * nloc) {
      __builtin_amdgcn_fence(__ATOMIC_RELEASE, "agent");
      asm volatile("s_waitcnt vmcnt(0)" ::: "memory");
      const unsigned og = xb_add(&bar[XB_TOP], 1u);
      const unsigned tg = og / nx;
      if (og + 1u == (tg + 1u) * nx) xb_add(&bar[XB_TOPGEN], 1u);
      else XB_SPIN(xb_ld(&bar[XB_TOPGEN]) == tg, bar);
      __builtin_amdgcn_fence(__ATOMIC_ACQUIRE, "agent");
      xb_add(&bar[XB_XGEN(b.x)], 1u);
      asm volatile("s_waitcnt vmcnt(0)" ::: "memory");
    } else {
      XB_SPIN(xb_ld(&bar[XB_XGEN(b.x)]) == gen, bar);
      __builtin_amdgcn_fence(__ATOMIC_ACQUIRE, "agent");
      asm volatile("s_waitcnt vmcnt(0)" ::: "memory");
    }
  }
  __syncthreads();
}

__global__ void __launch_bounds__(256, 2) hybrid_megakernel(Params p) {
  extern __shared__ __attribute__((aligned(16))) char smem[];
  cg::grid_group grid = cg::this_grid();
  if (threadIdx.x < 28) ((const float**)(p.ws + OFF_TBL))[threadIdx.x] = p.in[threadIdx.x];
  if (blockIdx.x == 0) {
    ((int*)(p.ws + OFF_WQ))[threadIdx.x] = 0;
    for (int i = threadIdx.x; i < XCD_BAR_WORDS; i += 256) ((unsigned*)(p.ws + OFF_BAR))[i] = 0u;
  }
  volatile LAS unsigned* xst = (volatile LAS unsigned*)(smem + LDS_BYTES - 32);
  if (threadIdx.x == 0) { xst[0] = 0u; xst[1] = 0u; }
  __syncthreads();
  __threadfence();
  grid.sync();
  (void)xcd_barrier_post((unsigned*)(p.ws + OFF_BAR), xst);
#define GSYNC() { XcdBarrier xb_; { char* w_ = p.ws; asm volatile("" : "+s"(w_)); xb_.bar = (unsigned*)(w_ + OFF_BAR); } xb_.x = xb_xcc_id(); xb_.st = (volatile LAS unsigned*)(smem + LDS_BYTES - 32); xcd_barrier(xb_); }
#define LQ Params q = p; { char* w_ = q.ws; asm volatile("" : "+s"(w_)); q.ws = w_; }
  { LQ phase0(q, smem); }
  GSYNC();
  { LQ phase_modred(q); }
  GSYNC();
#pragma unroll 1
  for (int l = 0; l < NL; l++) {
    for (int rep = 0; rep < REP_SMALL; rep++) { { LQ phase_norm(q, l); } GSYNC(); }
    for (int rep = 0; rep < REP_INPROJ; rep++) { { LQ phase_inproj(q, l, smem); } GSYNC(); }
    for (int rep = 0; rep < REP_SMALL; rep++) { { LQ phase_prep(q, l); } GSYNC(); }
    for (int rep = 0; rep < REP_MLAUP; rep++) { { LQ phase_mlaup(q, l, smem, rep); } GSYNC(); }
    for (int rep = 0; rep < REP_SMALL; rep++) { { LQ phase_prep2(q, l); } GSYNC(); }
    for (int rep = 0; rep < REP_MIX; rep++) { { LQ phase_mix(q, l, smem, rep); } GSYNC(); }
    for (int rep = 0; rep < REP_SMALL; rep++) { { LQ phase_post(q, l); } GSYNC(); }
    { LQ phase_outproj(q, l, smem); }
    if (l + 1 < NL) GSYNC();
  }
}

extern "C" void kernel_launch(void* const* d_in, const int* in_sizes, int n_in, void* d_out, int out_size, void* d_ws,
                              size_t ws_size, hipStream_t stream) {
  static int grid_blocks = 0;
  if (grid_blocks == 0) {
    if (n_in != 28 || ws_size < WS_END) {
      fprintf(stderr, "kernel_launch: need 28 inputs and %zu bytes ws; got %d, %zu\n", (size_t)WS_END, n_in, ws_size);
      grid_blocks = -1;
      return;
    }
    int dev = 0, cus = 0, per_cu = 0;
    hipGetDevice(&dev);
    hipDeviceGetAttribute(&cus, hipDeviceAttributeMultiprocessorCount, dev);
    hipFuncSetAttribute((const void*)hybrid_megakernel, hipFuncAttributeMaxDynamicSharedMemorySize, LDS_BYTES);
    hipOccupancyMaxActiveBlocksPerMultiprocessor(&per_cu, (const void*)hybrid_megakernel, 256, LDS_BYTES);
    if (per_cu < 1) per_cu = 1;
    if (per_cu > 2) per_cu = 2;
    grid_blocks = cus * per_cu;
    fprintf(stderr, "kernel_launch: cus=%d per_cu=%d grid=%d ws_need=%zu ws=%zu\n", cus, per_cu, grid_blocks, (size_t)WS_END, ws_size);
  }
  if (grid_blocks < 0) return;
  Params p{};
  for (int i = 0; i < 28; i++) p.in[i] = (const float*)d_in[i];
  p.out = (float*)d_out;
  p.ws = (char*)d_ws;
  void* args[] = {&p};
  hipError_t e = hipLaunchCooperativeKernel((const void*)hybrid_megakernel, dim3(grid_blocks), dim3(256), args, LDS_BYTES, stream);
  if (e != hipSuccess) fprintf(stderr, "cooperative launch failed: %s (grid %d)\n", hipGetErrorString(e), grid_blocks);
}

#ifdef PHASE_TEST
__global__ void __launch_bounds__(256, 2) t_phase0(Params p) { extern __shared__ __attribute__((aligned(16))) char smem[]; phase0(p, smem); }
__global__ void __launch_bounds__(256, 2) t_norm(Params p) { phase_norm(p, 1); }
__global__ void __launch_bounds__(256, 2) t_inproj(Params p) { extern __shared__ __attribute__((aligned(16))) char smem[]; phase_inproj(p, 1, smem); }
__global__ void __launch_bounds__(256, 2) t_prep(Params p) { phase_prep(p, 1); }
__global__ void __launch_bounds__(256, 2) t_gdnprep(Params p) { extern __shared__ __attribute__((aligned(16))) char smem[]; gdn_chunk_prep(p, bid_opaque(), smem); }
__global__ void __launch_bounds__(256, 2) t_mlaup(Params p) { extern __shared__ __attribute__((aligned(16))) char smem[]; phase_mlaup(p, 1, smem); }
__global__ void __launch_bounds__(256, 2) t_prep2(Params p) { phase_prep2(p, 1); }
__global__ void __launch_bounds__(256, 2) t_gdnchain(Params p) { extern __shared__ __attribute__((aligned(16))) char smem[]; gdn_chain(p, bid_opaque(), smem); }
__global__ void __launch_bounds__(256, 2) t_ssdchain(Params p) { extern __shared__ __attribute__((aligned(16))) char smem[]; ssd_chain(p, 1, bid_opaque(), smem); }
__global__ void __launch_bounds__(256, 2) t_mix(Params p) { extern __shared__ __attribute__((aligned(16))) char smem[]; phase_mix(p, 1, smem); }
__global__ void __launch_bounds__(256, 2) t_post(Params p) { phase_post(p, 1); }
__global__ void __launch_bounds__(256, 2) t_outproj(Params p) { extern __shared__ __attribute__((aligned(16))) char smem[]; phase_outproj(p, 1, smem); }
#endif
#ifdef PHASE_TEST
__global__ void __launch_bounds__(256, 2) t_attn192(Params p) { extern __shared__ __attribute__((aligned(16))) char smem[];
  KSeg s0{(const bf16_t*)wsb(p), (const bf16_t*)wsb(p), 256, 4}; KSeg s1{(const bf16_t*)wsb(p), (const bf16_t*)wsb(p), 4096, 64};
  attn_item<192, 2, false>(smem, (const bf16_t*)wsb(p), 768, s0, s1, 768, 0.1f, nullptr, 0, 0, (const bf16_t*)wsb(p), (bf16_t*)wsb(p), true); }
__global__ void __launch_bounds__(256, 2) t_attn128na(Params p) { extern __shared__ __attribute__((aligned(16))) char smem[];
  KSeg s0{(const bf16_t*)wsb(p), (const bf16_t*)wsb(p), 256, 4}; KSeg s1{(const bf16_t*)wsb(p), (const bf16_t*)wsb(p), 4096, 64};
  attn_item<128, 1, true>(smem, (const bf16_t*)wsb(p), 768, s0, s1, 768, 0.1f, inp(p, 14), bid_opaque(), 0, (const bf16_t*)wsb(p), (bf16_t*)wsb(p), true); }
__global__ void __launch_bounds__(256, 2) t_attn128(Params p) { extern __shared__ __attribute__((aligned(16))) char smem[];
  KSeg s0{(const bf16_t*)wsb(p), (const bf16_t*)wsb(p), 256, 4}; KSeg s1{(const bf16_t*)wsb(p), (const bf16_t*)wsb(p), 4096, 64};
  attn_item<128, 2, false>(smem, (const bf16_t*)wsb(p), 768, s0, s1, 768, 0.1f, nullptr, 0, 0, (const bf16_t*)wsb(p), (bf16_t*)wsb(p), true); }
#endif
```
